# Optimizing an MI355X kernel written in HIP

```python
import math
import jax, jax.numpy as jnp
from jax import lax
import numpy as np

D_MODEL = 1024
BATCH = 8
SEQ = 4096
DEPTH = 2

CHUNK = 64
N_EVEN = (DEPTH + 1) // 2
N_ODD = DEPTH // 2
EPS = 1e-6

S5_WIDTH = D_MODEL
S5_GROUP = 16
S5_GROUPS = S5_WIDTH // S5_GROUP
S5_STATE = 64

RET_HEADS = 8
RET_DK = D_MODEL // (2 * RET_HEADS)
RET_DV = D_MODEL // RET_HEADS
RET_QK = RET_HEADS * RET_DK
RET_WIDTH = RET_HEADS * RET_DV
ROPE_BASE = 10000.0

AB_IN = 2 * S5_WIDTH + 2 * RET_QK + 2 * RET_WIDTH
AB_MIX = S5_WIDTH + RET_WIDTH

CONV_WIDTH = D_MODEL
CONV_K = 31
C_IN = 3 * CONV_WIDTH

kernel_name = 'hybrid_s5_retention_conformer_conv'


def rmsnorm(x, g):
    xf = x.astype(jnp.float32)
    y = xf * lax.rsqrt(jnp.mean(xf * xf, axis=-1, keepdims=True) + EPS)
    return (y * g.astype(jnp.float32)).astype(x.dtype)


def _complex_affine_combine(e1, e2):
    a1r, a1i, b1r, b1i = e1
    a2r, a2i, b2r, b2i = e2
    ar = a2r * a1r - a2i * a1i
    ai = a2r * a1i + a2i * a1r
    br = a2r * b1r - a2i * b1i + b2r
    bi = a2r * b1i + a2i * b1r + b2i
    return ar, ai, br, bi


def s5_mixer(u, a_re, a_im, log_dt, b_re, b_im, c_re, c_im, d_skip, glu_w, glu_b):
    f32 = jnp.float32
    bsz, seq, _ = u.shape
    n_chunks = seq // CHUNK
    uf = u.astype(f32)
    are, aim = a_re.astype(f32), a_im.astype(f32)
    dt = jnp.exp(log_dt.astype(f32))[:, None]
    mag = jnp.exp(are * dt)
    lb_re = mag * jnp.cos(aim * dt)
    lb_im = mag * jnp.sin(aim * dt)
    nr, ni = lb_re - 1.0, lb_im
    den = are * are + aim * aim
    coef_re = (nr * are + ni * aim) / den
    coef_im = (ni * are - nr * aim) / den
    bre, bim = b_re.astype(f32), b_im.astype(f32)
    bb_re = coef_re[..., None] * bre - coef_im[..., None] * bim
    bb_im = coef_re[..., None] * bim + coef_im[..., None] * bre
    cre, cim = c_re.astype(f32), c_im.astype(f32)
    dsk = d_skip.astype(f32).reshape(S5_GROUPS, S5_GROUP)
    a_r = jnp.broadcast_to(lb_re, (CHUNK, 1, S5_GROUPS, S5_STATE))
    a_i = jnp.broadcast_to(lb_im, (CHUNK, 1, S5_GROUPS, S5_STATE))

    u_blk = uf.reshape(bsz, n_chunks, CHUNK, S5_GROUPS, S5_GROUP).transpose(1, 2, 0, 3, 4)

    def chunk_step(carry, u_c):
        s_re, s_im = carry
        bu_re = jnp.einsum('tbgh,gnh->tbgn', u_c, bb_re)
        bu_im = jnp.einsum('tbgh,gnh->tbgn', u_c, bb_im)
        pr, pim, zr, zi = lax.associative_scan(
            _complex_affine_combine, (a_r, a_i, bu_re, bu_im), axis=0)
        xr = zr + pr * s_re - pim * s_im
        xi = zi + pr * s_im + pim * s_re
        y = (jnp.einsum('tbgn,ghn->tbgh', xr, cre)
             - jnp.einsum('tbgn,ghn->tbgh', xi, cim)
             + dsk * u_c)
        return (xr[-1], xi[-1]), y

    init = (jnp.zeros((bsz, S5_GROUPS, S5_STATE), f32),
            jnp.zeros((bsz, S5_GROUPS, S5_STATE), f32))
    _, y = lax.scan(chunk_step, init, u_blk)
    y = y.transpose(2, 0, 1, 3, 4).reshape(bsz, seq, S5_WIDTH)
    y = jax.nn.gelu(y)
    y = y * jax.nn.sigmoid(y @ glu_w.astype(f32) + glu_b.astype(f32))
    return y.astype(u.dtype)


def rope(x, positions):
    half = x.shape[-1] // 2
    freqs = ROPE_BASE ** (-jnp.arange(half, dtype=jnp.float32) / half)
    ang = positions.astype(jnp.float32)[:, None] * freqs[None, :]
    cos = jnp.cos(ang)[None, :, None, :]
    sin = jnp.sin(ang)[None, :, None, :]
    x1, x2 = x[..., :half], x[..., half:]
    return jnp.concatenate([x1 * cos - x2 * sin, x1 * sin + x2 * cos], axis=-1)


def retention(q, k, v):
    f32 = jnp.float32
    bsz, seq = q.shape[0], q.shape[1]
    n_chunks = seq // CHUNK
    positions = jnp.arange(seq, dtype=jnp.int32)
    q = rope(q.astype(f32), positions) * (RET_DK ** -0.5)
    k = rope(k.astype(f32), positions)
    v = v.astype(f32)
    log_g = jnp.log(1.0 - 2.0 ** (-5.0 - jnp.arange(RET_HEADS, dtype=f32)))
    idx = jnp.arange(CHUNK, dtype=f32)
    intra = jnp.exp(log_g[:, None, None] * jnp.abs(idx[:, None] - idx[None, :]))
    qc = q.reshape(bsz, n_chunks, CHUNK, RET_HEADS, RET_DK)
    kc = k.reshape(bsz, n_chunks, CHUNK, RET_HEADS, RET_DK)
    vc = v.reshape(bsz, n_chunks, CHUNK, RET_HEADS, RET_DV)
    scores = jnp.einsum('bnihd,bnjhd->bnhij', qc, kc) * intra
    intra_out = jnp.einsum('bnhij,bnjhe->bnihe', scores, vc)
    k_dec = jnp.exp(log_g[None, :] * (CHUNK - 1 - idx)[:, None])
    kv = jnp.einsum('bnjhd,jh,bnjhe->bnhde', kc, k_dec, vc)
    chunk_decay = jnp.exp(log_g * CHUNK)[:, None, None]

    def state_step(s, kv_n):
        return chunk_decay * s + kv_n, s

    _, s_prev = lax.scan(state_step, jnp.zeros((bsz, RET_HEADS, RET_DK, RET_DV), f32),
                         kv.transpose(1, 0, 2, 3, 4))
    s_prev = s_prev.transpose(1, 0, 2, 3, 4)
    q_dec = jnp.exp(log_g[None, :] * (idx + 1.0)[:, None])
    cross = jnp.einsum('bnihd,ih,bnhde->bnihe', qc, q_dec, s_prev)
    out = (intra_out + cross).reshape(bsz, seq, RET_HEADS, RET_DV)
    mu = jnp.mean(out, axis=-1, keepdims=True)
    var = jnp.mean(jnp.square(out - mu), axis=-1, keepdims=True)
    out = (out - mu) * lax.rsqrt(var + EPS)
    return out.reshape(bsz, seq, RET_WIDTH)


def mixer_ab(h, w_in, a_re, a_im, log_dt, b_re, b_im, c_re, c_im, d_skip,
             glu_w, glu_b, w_out):
    bsz, seq, _ = h.shape
    proj = h @ w_in
    cuts = np.cumsum([S5_WIDTH, S5_WIDTH, RET_QK, RET_QK, RET_WIDTH]).tolist()
    u_s5, g_s5, q, k, v, g_ret = jnp.split(proj, cuts, axis=-1)
    y_s5 = s5_mixer(u_s5, a_re, a_im, log_dt, b_re, b_im, c_re, c_im, d_skip, glu_w, glu_b)
    y_s5 = y_s5 * jax.nn.silu(g_s5)
    q = q.reshape(bsz, seq, RET_HEADS, RET_DK)
    k = k.reshape(bsz, seq, RET_HEADS, RET_DK)
    v = v.reshape(bsz, seq, RET_HEADS, RET_DV)
    y_ret = retention(q, k, v).astype(h.dtype) * jax.nn.silu(g_ret)
    return jnp.concatenate([y_s5, y_ret], axis=-1) @ w_out


def mixer_conv(h, w_in, conv_w, conv_b, ln_g, ln_b, w_out):
    proj = h @ w_in
    a, b, g = jnp.split(proj, 3, axis=-1)
    u = a * jax.nn.sigmoid(b)
    u = lax.conv_general_dilated(
        u, conv_w[:, None, :].astype(u.dtype), window_strides=(1,),
        padding=[(CONV_K - 1, 0)], dimension_numbers=('NWC', 'WIO', 'NWC'),
        feature_group_count=CONV_WIDTH) + conv_b
    uf = u.astype(jnp.float32)
    mu = jnp.mean(uf, axis=-1, keepdims=True)
    var = jnp.mean(jnp.square(uf - mu), axis=-1, keepdims=True)
    uf = (uf - mu) * lax.rsqrt(var + EPS) * ln_g.astype(jnp.float32) + ln_b.astype(jnp.float32)
    u = jax.nn.silu(uf).astype(h.dtype) * jax.nn.silu(g)
    return u @ w_out


def setup_inputs(seed: int = 0) -> dict:
    key = jax.random.key(seed)
    ks = jax.random.split(key, 24)
    f32 = jnp.float32
    nrm = lambda k, shape, s: jax.random.normal(k, shape, f32) * s
    G, N, H = S5_GROUPS, S5_STATE, S5_GROUP
    a_re = -0.5 + nrm(ks[4], (N_EVEN, G, N), 0.01)
    a_im = math.pi * jnp.arange(N, dtype=f32)[None, None, :] + nrm(ks[5], (N_EVEN, G, N), 0.01)
    log_dt = jax.random.uniform(ks[6], (N_EVEN, G), f32, math.log(1e-3), math.log(1e-1))
    return {
        'x': nrm(ks[0], (BATCH, SEQ, D_MODEL), 1.0),
        'norm_g': 1.0 + nrm(ks[1], (DEPTH, D_MODEL), 0.01),
        'final_g': 1.0 + nrm(ks[2], (D_MODEL,), 0.01),
        'w_in_ab': nrm(ks[3], (N_EVEN, D_MODEL, AB_IN), D_MODEL ** -0.5),
        's5_a_re': a_re,
        's5_a_im': a_im,
        's5_log_dt': log_dt,
        's5_b_re': nrm(ks[7], (N_EVEN, G, N, H), (2.0 * H) ** -0.5),
        's5_b_im': nrm(ks[8], (N_EVEN, G, N, H), (2.0 * H) ** -0.5),
        's5_c_re': nrm(ks[9], (N_EVEN, G, H, N), (2.0 * N) ** -0.5),
        's5_c_im': nrm(ks[10], (N_EVEN, G, H, N), (2.0 * N) ** -0.5),
        's5_d': nrm(ks[11], (N_EVEN, S5_WIDTH), 1.0),
        's5_glu_w': nrm(ks[12], (N_EVEN, S5_WIDTH, S5_WIDTH), S5_WIDTH ** -0.5),
        's5_glu_b': nrm(ks[13], (N_EVEN, S5_WIDTH), 0.01),
        'w_out_ab': nrm(ks[14], (N_EVEN, AB_MIX, D_MODEL), AB_MIX ** -0.5),
        'w_in_c': nrm(ks[15], (N_ODD, D_MODEL, C_IN), D_MODEL ** -0.5),
        'conv_w': nrm(ks[16], (N_ODD, CONV_K, CONV_WIDTH), CONV_K ** -0.5),
        'conv_b': nrm(ks[17], (N_ODD, CONV_WIDTH), 0.01),
        'conv_ln_g': 1.0 + nrm(ks[18], (N_ODD, CONV_WIDTH), 0.01),
        'conv_ln_b': nrm(ks[19], (N_ODD, CONV_WIDTH), 0.01),
        'w_out_c': nrm(ks[20], (N_ODD, CONV_WIDTH, D_MODEL), CONV_WIDTH ** -0.5),
    }


def reference(x, norm_g, final_g, w_in_ab, s5_a_re, s5_a_im, s5_log_dt, s5_b_re,
              s5_b_im, s5_c_re, s5_c_im, s5_d, s5_glu_w, s5_glu_b, w_out_ab,
              w_in_c, conv_w, conv_b, conv_ln_g, conv_ln_b, w_out_c):
    for layer in range(DEPTH):
        h = rmsnorm(x, norm_g[layer])
        i = layer // 2
        if layer % 2 == 0:
            x = x + mixer_ab(h, w_in_ab[i], s5_a_re[i], s5_a_im[i], s5_log_dt[i],
                             s5_b_re[i], s5_b_im[i], s5_c_re[i], s5_c_im[i], s5_d[i],
                             s5_glu_w[i], s5_glu_b[i], w_out_ab[i])
        else:
            x = x + mixer_conv(h, w_in_c[i], conv_w[i], conv_b[i], conv_ln_g[i],
                               conv_ln_b[i], w_out_c[i])
    return rmsnorm(x, final_g)
```

```cpp
#include <hip/hip_runtime.h>
#include <hip/hip_cooperative_groups.h>
#include <cstdio>
#include <cstdint>
namespace cg = cooperative_groups;

namespace pg8 {
#define PG8_LAS __attribute__((address_space(3)))
typedef unsigned short bf16_t;
typedef short bf16x8 __attribute__((ext_vector_type(8)));
typedef float f32x4 __attribute__((ext_vector_type(4)));
typedef float f32x2 __attribute__((ext_vector_type(2)));
typedef unsigned u32x4 __attribute__((ext_vector_type(4)));
typedef unsigned u32x2 __attribute__((ext_vector_type(2)));
constexpr int BM = 256, BK = 64, HALF = 128, HTB = HALF * BK * 2  , STAGE_BYTES = 8 * HTB, NXCD = 8, WGM = 8;

__host__ __device__ __forceinline__ int lds_byte(int r, int c) { const int st = (r >> 4) * 2 + (c >> 5), rr = r & 15, cc = c & 31, ob = rr * 64 + cc * 2; return st * 1024 + (ob ^ (((ob >> 9) & 1) << 5)); }
__host__ __device__ __forceinline__ void stage_rc(int b, int& R, int& C) { const int st = b / 1024, sb = b % 1024, swz = sb ^ (((sb >> 9) & 1) << 5); R = (st >> 1) * 16 + swz / 64; C = (st & 1) * 32 + (swz % 64) / 2; }
__host__ __device__ __forceinline__ int perm32(int rho) { const int n = rho >> 4, i = rho & 15; return 8 * (i >> 2) + 4 * n + (i & 3); }

struct Unit { int pm, pn; };
struct Gemm { const bf16_t* A; const bf16_t* Bt; int K, lda, ldb, amode, gM; };

struct StaticOrder {
    int nM, nN, nwg, G, c;
    __host__ __device__ void init(int M, int N, int G_, int c_) { nM = M / BM; nN = N / BM; nwg = nM * nN; G = G_; c = c_; }
    __host__ __device__ bool next(int i, Unit& u) const {
        const long L = (long)i * G + c; if (L >= nwg) return false;
        int wgid = (int)L; { const int q = nwg / NXCD, r = nwg % NXCD, xcd = wgid % NXCD, off = wgid / NXCD; wgid = (xcd < r ? xcd * (q + 1) : r * (q + 1) + (xcd - r) * q) + off; }
        const int nig = WGM * nN, gid = wgid / nig, fm = gid * WGM, gsz = (nM - fm) < WGM ? (nM - fm) : WGM;
        u.pm = fm + ((wgid % nig) % gsz); u.pn = (wgid % nig) / gsz; return true;
    }
};
struct GroupOrder {
    int G, c;
    __host__ __device__ bool next(int i, Unit& u) const { const int L = i * G + c; if (L >= 512) return false; u.pm = L; u.pn = L >> 3; return true; }
};

__device__ __forceinline__ unsigned cvt_pk_bf16(float lo, float hi) { unsigned r; asm volatile("v_cvt_pk_bf16_f32 %0, %1, %2" : "=v"(r) : "v"(lo), "v"(hi)); return r; }

template <class Epi, class Sched, bool ALIGN_EPI, bool SKIPB1>
__device__ __forceinline__ void gemm_phase(PG8_LAS unsigned char* lds, const Gemm g, const Sched& S, const Epi& E) {
    const int tid = threadIdx.x, wid = __builtin_amdgcn_readfirstlane(tid >> 6), lane = tid & 63, wr = wid >> 2, wc = wid & 3, fr = lane & 15, fq = lane >> 4;
    const int K = g.K, nt = K / BK;
    unsigned voffA[2], voffB[2];
#pragma unroll
    for (int i = 0; i < 2; ++i) { int R, C; stage_rc(tid * 16 + i * 8192, R, C); const int Rb = Epi::PERM ? ((R & ~31) + perm32(R & 31)) : R;
        voffA[i] = g.amode ? (unsigned)(((C >> 4) * g.gM + R) * 16 + (C & 15)) * 2u : (unsigned)(R * g.lda + C) * 2u;
        voffB[i] = (unsigned)(Rb * g.ldb + C) * 2u; }
    const size_t kstepA = g.amode ? (size_t)g.gM * 128 : (size_t)(BK * 2);
    const size_t kstepB = (size_t)(BK * 2);
    const size_t hstepA = g.amode ? (size_t)HALF * 32 : (size_t)HALF * g.lda * 2;
    const size_t hstepB = (size_t)HALF * g.ldb * 2;
    const size_t tstepA = 2 * hstepA, tstepB = 2 * hstepB;
    const unsigned ldsw = (unsigned)wid * 1024u;
    const int aoff = lds_byte(wr * 64 + fr, fq * 8), boff = lds_byte(wc * 32 + fr, fq * 8);
#define PG8_SA(b, h) (((b) * 2 + (h)) * HTB)
#define PG8_SB(b, h) ((4 + (b) * 2 + (h)) * HTB)
#define PG8_STAGE(bufoff, gbase, voff) do { _Pragma("unroll") for (int _i = 0; _i < 2; ++_i) \
        __builtin_amdgcn_global_load_lds((const unsigned*)((const char*)(gbase) + (voff)[_i]), (PG8_LAS unsigned*)(lds + (bufoff) + ldsw + _i * 8192), 16, 0, 0); } while (0)
#define PG8_LDA(dst, b, h) do { _Pragma("unroll") for (int m = 0; m < 4; ++m) _Pragma("unroll") for (int k = 0; k < 2; ++k) dst[m][k] = *(const PG8_LAS bf16x8*)(lds + PG8_SA(b, h) + aoff + m * 2048 + k * 1024); } while (0)
#define PG8_LDB(dst, b, h) do { _Pragma("unroll") for (int n = 0; n < 2; ++n) _Pragma("unroll") for (int k = 0; k < 2; ++k) dst[n][k] = *(const PG8_LAS bf16x8*)(lds + PG8_SB(b, h) + boff + n * 2048 + k * 1024); } while (0)
#define PG8_MMA(ai, bj, At, Bt) do { __builtin_amdgcn_s_setprio(1); _Pragma("unroll") for (int m = 0; m < 4; ++m) _Pragma("unroll") for (int n = 0; n < 2; ++n) _Pragma("unroll") for (int k = 0; k < 2; ++k) \
        acc[ai][bj][m][n] = __builtin_amdgcn_mfma_f32_16x16x32_bf16(Bt[n][k], At[m][k], acc[ai][bj][m][n], 0, 0, 0); __builtin_amdgcn_s_setprio(0); } while (0)
#define PG8_MMA1(ai, At, Bt) do { if constexpr (!SKIPB1) PG8_MMA(ai, 1, At, Bt); } while (0)
#define PG8_WAIT_V(n) asm volatile("s_waitcnt vmcnt(" #n ")" ::: "memory")
#define PG8_WAIT_L(n) asm volatile("s_waitcnt lgkmcnt(" #n ")" ::: "memory")
#define PG8_BAR __builtin_amdgcn_s_barrier()
#define PG8_SCHED __builtin_amdgcn_sched_barrier(0)
    Unit cur, nxt; int ui = 0;
    if (!S.next(0, cur)) return;
    f32x4 acc[2][2][4][2];
#pragma unroll
    for (int a = 0; a < 2; ++a)
#pragma unroll
        for (int b = 0; b < 2; ++b)
#pragma unroll
            for (int m = 0; m < 4; ++m)
#pragma unroll
                for (int n = 0; n < 2; ++n) acc[a][b][m][n] = (f32x4){0.f, 0.f, 0.f, 0.f};
    bf16x8 At[4][2], B0[2][2], B1[2][2];
    const char* cA = (const char*)g.A + (size_t)cur.pm * tstepA; const char* cB = (const char*)g.Bt + (size_t)cur.pn * tstepB;
    PG8_STAGE(PG8_SB(0, 0), cB, voffB); PG8_STAGE(PG8_SB(0, 1), cB + hstepB, voffB); PG8_STAGE(PG8_SA(0, 0), cA, voffA); PG8_STAGE(PG8_SA(0, 1), cA + hstepA, voffA);
    if (wr == 1) PG8_BAR;
    PG8_WAIT_V(2); PG8_BAR;
    PG8_STAGE(PG8_SB(1, 0), cB + kstepB, voffB); PG8_STAGE(PG8_SA(1, 0), cA + kstepA, voffA); PG8_STAGE(PG8_SB(1, 1), cB + hstepB + kstepB, voffB);
    PG8_WAIT_V(6); PG8_BAR;
    for (;;) {
        const bool has_next = S.next(ui + 1, nxt);
        const char* nA = has_next ? (const char*)g.A + (size_t)nxt.pm * tstepA : cA; const char* nB = has_next ? (const char*)g.Bt + (size_t)nxt.pn * tstepB : cB;
        for (int t = 0; t < nt; t += 2) {
            const bool last = (t == nt - 2);
            const char* a1 = cA + (size_t)(t + 1) * kstepA;
            const char* a2 = last ? nA : cA + (size_t)(t + 2) * kstepA; const char* b2 = last ? nB : cB + (size_t)(t + 2) * kstepB;
            const char* a3 = a2 + kstepA; const char* b3 = b2 + kstepB;
            PG8_LDB(B0, 0, 0); PG8_LDB(B1, 0, 1); PG8_SCHED; PG8_LDA(At, 0, 0); PG8_STAGE(PG8_SA(1, 1), a1 + hstepA, voffA);
            PG8_WAIT_V(8); PG8_WAIT_L(0); PG8_BAR; PG8_MMA(0, 0, At, B0); PG8_MMA1(0, At, B1); PG8_BAR; PG8_SCHED;
            PG8_LDA(At, 0, 1); PG8_STAGE(PG8_SB(0, 0), b2, voffB); PG8_STAGE(PG8_SB(0, 1), b2 + hstepB, voffB); PG8_STAGE(PG8_SA(0, 0), a2, voffA);
            PG8_WAIT_V(8); PG8_WAIT_L(0); PG8_BAR; PG8_MMA(1, 0, At, B0); PG8_MMA1(1, At, B1); PG8_BAR; PG8_SCHED;
            PG8_LDB(B0, 1, 0); PG8_LDB(B1, 1, 1); PG8_SCHED; PG8_LDA(At, 1, 0); PG8_STAGE(PG8_SA(0, 1), a2 + hstepA, voffA);
            PG8_WAIT_V(8); PG8_WAIT_L(0); PG8_BAR; PG8_MMA(0, 0, At, B0); PG8_MMA1(0, At, B1); PG8_BAR; PG8_SCHED;
            PG8_LDA(At, 1, 1); PG8_STAGE(PG8_SB(1, 0), b3, voffB); PG8_STAGE(PG8_SB(1, 1), b3 + hstepB, voffB); PG8_STAGE(PG8_SA(1, 0), a3, voffA);
            PG8_WAIT_V(8); PG8_WAIT_L(0); PG8_BAR; PG8_MMA(1, 0, At, B0); PG8_MMA1(1, At, B1); PG8_BAR; PG8_SCHED;
        }
        if constexpr (ALIGN_EPI) { if (wr == 0) PG8_BAR; }
        E(acc, cur, wr, wc, fr, fq);
        if (!has_next) break;
#pragma unroll
        for (int a = 0; a < 2; ++a)
#pragma unroll
            for (int b = 0; b < 2; ++b)
#pragma unroll
                for (int m = 0; m < 4; ++m)
#pragma unroll
                    for (int n = 0; n < 2; ++n) acc[a][b][m][n] = (f32x4){0.f, 0.f, 0.f, 0.f};
        cur = nxt; cA = nA; cB = nB; ++ui;
        if constexpr (ALIGN_EPI) { if (wr == 1) PG8_BAR; }
    }
    PG8_WAIT_V(0);
    if constexpr (!ALIGN_EPI) { if (wr == 0) PG8_BAR; }
    PG8_BAR;
#undef PG8_SA
#undef PG8_SB
#undef PG8_STAGE
#undef PG8_LDA
#undef PG8_LDB
#undef PG8_MMA
#undef PG8_MMA1
#undef PG8_WAIT_V
#undef PG8_WAIT_L
#undef PG8_BAR
#undef PG8_SCHED
}
}

#define GAS __attribute__((address_space(1)))
#define LAS __attribute__((address_space(3)))
typedef unsigned short bf16;
typedef pg8::f32x4 f32x4;
typedef pg8::f32x2 f32x2;
typedef pg8::u32x4 u32x4;
typedef pg8::u32x2 u32x2;
typedef pg8::bf16x8 bf16x8;
constexpr int NWAVES = 8, NTHR = 512;
constexpr int M = 32768, DM = 1024, SEQ = 4096;
constexpr float EPS = 1e-6f;
constexpr size_t MiB = 1u << 20;
constexpr size_t WS_CTL = 0, CTL_ZERO_BYTES = 1 * MiB;
constexpr size_t WS_ROPE = 1 * MiB;
constexpr size_t WS_WIN = 2 * MiB, WS_WGLU = 12 * MiB, WS_WOUT = 14 * MiB, WS_WINC = 18 * MiB, WS_WOUTC = 24 * MiB;
constexpr size_t WS_TG = 26 * MiB, WS_WG = 38 * MiB, WS_L16 = 46 * MiB, WS_KVSEG = 48 * MiB;
constexpr size_t WS_XN = 64 * MiB;
constexpr size_t WS_AEXT = 128 * MiB;
constexpr size_t WS_SG5 = 224 * MiB, WS_Q = 288 * MiB, WS_K = 320 * MiB, WS_V = 352 * MiB, WS_SGR = 416 * MiB;
constexpr size_t WS_X1 = 128 * MiB, WS_U2 = 256 * MiB, WS_SG2 = 320 * MiB, WS_V2 = 384 * MiB, WS_END = 480 * MiB;
constexpr int LDS_BYTES = 147456;
constexpr int AEXT_LD = 384;

__device__ __forceinline__ float fsigmoid(float x) { return __builtin_amdgcn_rcpf(1.0f + __expf(-x)); }
__device__ __forceinline__ float fsilu(float x) { return x * fsigmoid(x); }
__device__ __forceinline__ float fgelu_tanh(float x) { const float u = 1.5957691216f * (x + 0.044715f * x * x * x); return x * fsigmoid(u); }
__device__ __forceinline__ unsigned f2bf(float f) { unsigned u = __builtin_bit_cast(unsigned, f); return (u + 0x7fffu + ((u >> 16) & 1u)) >> 16; }
__device__ __forceinline__ float bf2f(unsigned h) { return __builtin_bit_cast(float, h << 16); }
__device__ __forceinline__ unsigned pk2(float lo, float hi) { return pg8::cvt_pk_bf16(lo, hi); }
__device__ __forceinline__ u32x4 pack8(f32x4 a, f32x4 b) { u32x4 w; w.x = pk2(a[0], a[1]); w.y = pk2(a[2], a[3]); w.z = pk2(b[0], b[1]); w.w = pk2(b[2], b[3]); return w; }
__device__ __forceinline__ void unpack8(u32x4 w, f32x4& a, f32x4& b) {
    a[0] = bf2f(w.x & 0xffffu); a[1] = bf2f(w.x >> 16); a[2] = bf2f(w.y & 0xffffu); a[3] = bf2f(w.y >> 16);
    b[0] = bf2f(w.z & 0xffffu); b[1] = bf2f(w.z >> 16); b[2] = bf2f(w.w & 0xffffu); b[3] = bf2f(w.w >> 16); }
__device__ __forceinline__ float wave_sum(float v) {
#pragma unroll
    for (int o = 1; o < 64; o <<= 1) v += __shfl_xor(v, o);
    return v;
}

typedef f32x4 AccT[2][2][4][2];

struct EpiWin {
    static constexpr bool PERM = true;
    bf16 *Aext, *SG5, *Q, *Kb, *V, *SGR; const float *ropec, *ropes;
    __device__ __forceinline__ void operator()(const AccT& acc, const pg8::Unit& u, int wr, int wc, int fr, int fq) const {
        const int pn = u.pn, row0 = u.pm * 256 + wr * 64 + fr;
#pragma unroll
        for (int ai = 0; ai < 2; ++ai)
#pragma unroll
            for (int m = 0; m < 4; ++m) { const int row = row0 + ai * 128 + m * 16;
#pragma unroll
                for (int bj = 0; bj < 2; ++bj) { const int colt = pn * 256 + bj * 128 + wc * 32 + 8 * fq;
                    f32x4 v0 = acc[ai][bj][m][0], v1 = acc[ai][bj][m][1];
                    if (pn < 4) {
                        const int g = colt >> 4, h0 = colt & 15;
                        bf16* dst = Aext + (size_t)g * (2048 * AEXT_LD) + (size_t)(row >> 4) * AEXT_LD + (row & 15) * 16 + h0;
                        *(u32x4*)dst = pack8(v0, v1);
                    } else if (pn < 8) {
#pragma unroll
                        for (int i = 0; i < 4; ++i) { v0[i] = fsilu(v0[i]); v1[i] = fsilu(v1[i]); }
                        *(u32x4*)(SG5 + (size_t)row * 1024 + (colt - 1024)) = pack8(v0, v1);
                    } else if (pn < 12) {
                        const bool isq = pn < 10; const int c = colt - (isq ? 2048 : 2560); const int j = (c & 63) >> 3; const int pos = row & (SEQ - 1);
                        const f32x4 cs = *(const f32x4*)(ropec + pos * 32 + 4 * j), sn = *(const f32x4*)(ropes + pos * 32 + 4 * j);
                        const float sc = isq ? 0.125f : 1.0f;
                        f32x4 o1 = (v0 * cs - v1 * sn) * sc, o2 = (v0 * sn + v1 * cs) * sc;
                        *(u32x4*)((isq ? Q : Kb) + (size_t)row * 512 + c) = pack8(o1, o2);
                    } else if (pn < 16) {
                        *(u32x4*)(V + (size_t)row * 1024 + (colt - 3072)) = pack8(v0, v1);
                    } else {
#pragma unroll
                        for (int i = 0; i < 4; ++i) { v0[i] = fsilu(v0[i]); v1[i] = fsilu(v1[i]); }
                        *(u32x4*)(SGR + (size_t)row * 1024 + (colt - 4096)) = pack8(v0, v1);
                    } } }
    }
};
struct EpiSloc {
    static constexpr bool PERM = false;
    float* O;
    __device__ __forceinline__ void operator()(const AccT& acc, const pg8::Unit& u, int wr, int wc, int fr, int fq) const {
        const int row0 = u.pm * 256 + wr * 64 + fr, col0 = wc * 32 + 4 * fq;
#pragma unroll
        for (int ai = 0; ai < 2; ++ai)
#pragma unroll
            for (int m = 0; m < 4; ++m) { float* rowp = O + (size_t)(row0 + ai * 128 + m * 16) * 128 + col0;
#pragma unroll
                for (int n = 0; n < 2; ++n) *(f32x4*)(rowp + 16 * n) = acc[ai][0][m][n]; }
    }
};
struct EpiYg {
    static constexpr bool PERM = true;
    bf16* O;
    __device__ __forceinline__ void operator()(const AccT& acc, const pg8::Unit& u, int wr, int wc, int fr, int fq) const {
        const int row0 = u.pm * 256 + wr * 64 + fr, col0 = wc * 32 + 8 * fq;
#pragma unroll
        for (int ai = 0; ai < 2; ++ai)
#pragma unroll
            for (int m = 0; m < 4; ++m) { bf16* rowp = O + (size_t)(row0 + ai * 128 + m * 16) * 256 + col0;
#pragma unroll
                for (int bj = 0; bj < 2; ++bj) { f32x4 v0 = acc[ai][bj][m][0], v1 = acc[ai][bj][m][1];
#pragma unroll
                    for (int i = 0; i < 4; ++i) { v0[i] = fgelu_tanh(v0[i]); v1[i] = fgelu_tanh(v1[i]); }
                    *(u32x4*)(rowp + bj * 128) = pack8(v0, v1); } }
    }
};
struct EpiGlu {
    static constexpr bool PERM = true;
    const bf16* Yg; const bf16* SG5; const float* bias; bf16* Ymix;
    __device__ __forceinline__ void operator()(const AccT& acc, const pg8::Unit& u, int wr, int wc, int fr, int fq) const {
        const int row0 = u.pm * 256 + wr * 64 + fr, colb = u.pn * 256 + wc * 32 + 8 * fq;
        f32x4 bv[2][2];
#pragma unroll
        for (int bj = 0; bj < 2; ++bj)
#pragma unroll
            for (int n = 0; n < 2; ++n) bv[bj][n] = *(const f32x4*)(bias + colb + bj * 128 + 4 * n);
#pragma unroll
        for (int ai = 0; ai < 2; ++ai)
#pragma unroll
            for (int m = 0; m < 4; ++m) { const int row = row0 + ai * 128 + m * 16;
#pragma unroll
                for (int bj = 0; bj < 2; ++bj) { const int c = colb + bj * 128;
                    const u32x4 yw = *(const u32x4*)(Yg + ((size_t)(c >> 4) * M + row) * 16 + (c & 15));
                    const u32x4 gw = *(const u32x4*)(SG5 + (size_t)row * 1024 + c);
                    f32x4 y0, y1, g0, g1; unpack8(yw, y0, y1); unpack8(gw, g0, g1);
                    f32x4 z0 = acc[ai][bj][m][0] + bv[bj][0], z1 = acc[ai][bj][m][1] + bv[bj][1];
#pragma unroll
                    for (int i = 0; i < 4; ++i) { z0[i] = y0[i] * fsigmoid(z0[i]) * g0[i]; z1[i] = y1[i] * fsigmoid(z1[i]) * g1[i]; }
                    *(u32x4*)(Ymix + (size_t)row * 2048 + c) = pack8(z0, z1); }
                asm volatile("" ::: "memory"); }
    }
};
struct EpiWout {
    static constexpr bool PERM = false;
    const float* X; float* X1; bf16* XG2; const float* g1; float* ss1;
    __device__ __forceinline__ void operator()(const AccT& acc, const pg8::Unit& u, int wr, int wc, int fr, int fq) const {
        const int row0 = u.pm * 256 + wr * 64 + fr, colb = u.pn * 256 + wc * 32 + 4 * fq;
        f32x4 gv[2][2];
#pragma unroll
        for (int bj = 0; bj < 2; ++bj)
#pragma unroll
            for (int n = 0; n < 2; ++n) gv[bj][n] = *(const f32x4*)(g1 + colb + bj * 128 + 16 * n);
#pragma unroll
        for (int ai = 0; ai < 2; ++ai)
#pragma unroll
            for (int m = 0; m < 4; ++m) { const int row = row0 + ai * 128 + m * 16; const size_t off = (size_t)row * 1024 + colb; float s = 0.f;
#pragma unroll
                for (int bj = 0; bj < 2; ++bj)
#pragma unroll
                    for (int n = 0; n < 2; ++n) { const f32x4 xv = *(const f32x4*)(X + off + bj * 128 + 16 * n); const f32x4 x1 = xv + acc[ai][bj][m][n];
                        *(f32x4*)(X1 + off + bj * 128 + 16 * n) = x1; s += (x1[0] * x1[0] + x1[1] * x1[1]) + (x1[2] * x1[2] + x1[3] * x1[3]);
                        const f32x4 xg = x1 * gv[bj][n]; u32x2 w; w.x = pk2(xg[0], xg[1]); w.y = pk2(xg[2], xg[3]); *(u32x2*)(XG2 + off + bj * 128 + 16 * n) = w; }
                s += __shfl_xor(s, 16); s += __shfl_xor(s, 32);
                if (fq == 0) atomicAdd(ss1 + row, s);
                asm volatile("" ::: "memory"); }
    }
};
struct EpiWinC {
    static constexpr bool PERM = true;
    const float* ss1; bf16* U2; bf16* SG2;
    __device__ __forceinline__ void operator()(const AccT& acc, const pg8::Unit& u, int wr, int wc, int fr, int fq) const {
        const int pn = u.pn, row0 = u.pm * 256 + wr * 64 + fr;
#pragma unroll
        for (int ai = 0; ai < 2; ++ai)
#pragma unroll
            for (int m = 0; m < 4; ++m) { const int row = row0 + ai * 128 + m * 16; const float r = rsqrtf(ss1[row] * (1.0f / 1024.0f) + EPS);
                if (pn < 8) {
                    f32x4 a0 = acc[ai][0][m][0] * r, a1 = acc[ai][0][m][1] * r, b0 = acc[ai][1][m][0] * r, b1 = acc[ai][1][m][1] * r;
#pragma unroll
                    for (int i = 0; i < 4; ++i) { a0[i] *= fsigmoid(b0[i]); a1[i] *= fsigmoid(b1[i]); }
                    *(u32x4*)(U2 + (size_t)row * 1024 + pn * 128 + wc * 32 + 8 * fq) = pack8(a0, a1);
                } else {
#pragma unroll
                    for (int bj = 0; bj < 2; ++bj) { f32x4 v0 = acc[ai][bj][m][0] * r, v1 = acc[ai][bj][m][1] * r;
#pragma unroll
                        for (int i = 0; i < 4; ++i) { v0[i] = fsilu(v0[i]); v1[i] = fsilu(v1[i]); }
                        *(u32x4*)(SG2 + (size_t)row * 1024 + (pn - 8) * 256 + bj * 128 + wc * 32 + 8 * fq) = pack8(v0, v1); }
                } }
    }
};
struct EpiWoutC {
    static constexpr bool PERM = false;
    const float* X1; float* O;
    __device__ __forceinline__ void operator()(const AccT& acc, const pg8::Unit& u, int wr, int wc, int fr, int fq) const {
        const int row0 = u.pm * 256 + wr * 64 + fr, colb = u.pn * 256 + wc * 32 + 4 * fq;
#pragma unroll
        for (int ai = 0; ai < 2; ++ai)
#pragma unroll
            for (int m = 0; m < 4; ++m) { const size_t off = (size_t)(row0 + ai * 128 + m * 16) * 1024 + colb;
#pragma unroll
                for (int bj = 0; bj < 2; ++bj)
#pragma unroll
                    for (int n = 0; n < 2; ++n) { const f32x4 xv = *(const f32x4*)(X1 + off + bj * 128 + 16 * n); *(f32x4*)(O + off + bj * 128 + 16 * n) = xv + acc[ai][bj][m][n]; }
                asm volatile("" ::: "memory"); }
    }
};

#define LDS_WAIT() asm volatile("s_waitcnt lgkmcnt(0)" ::: "memory")
__device__ __forceinline__ int dest_row(int n, int mode) {
    if (mode == 1) { if (n >= 2048 && n < 3072) { const int d = n & 63; return (n & ~63) + 8 * ((d & 31) >> 2) + 4 * (d >> 5) + (d & 3); } return n; }
    if (mode == 2) { if (n < 1024) return 256 * (n >> 7) + (n & 127); if (n < 2048) { const int q = n - 1024; return 256 * (q >> 7) + 128 + (q & 127); } return n; }
    return n;
}
__device__ __forceinline__ void p0_transpose_item(const float* W, int K, int N, bf16* WT, int mode, LAS float* scr, int item, int lane) {
    const int nblk = N / 32, kb = item / nblk, nb = item % nblk, k0 = 64 * kb, n0 = 32 * nb;
#pragma unroll 8
    for (int i = 0; i < 32; ++i) { const int kk = 2 * i + (lane >> 5); scr[kk * 33 + (lane & 31)] = W[(size_t)(k0 + kk) * N + n0 + (lane & 31)]; }
    LDS_WAIT(); asm volatile("" ::: "memory");
    const int c = lane & 7;
#pragma unroll
    for (int j = 0; j < 4; ++j) { const int n = (lane >> 3) + 8 * j; const LAS float* s = scr + (8 * c) * 33 + n;
        u32x4 o; o.x = pk2(s[0 * 33], s[1 * 33]); o.y = pk2(s[2 * 33], s[3 * 33]); o.z = pk2(s[4 * 33], s[5 * 33]); o.w = pk2(s[6 * 33], s[7 * 33]);
        *(u32x4*)(WT + (size_t)dest_row(n0 + n, mode) * K + k0 + 8 * c) = o; }
    LDS_WAIT(); asm volatile("" ::: "memory");
}
__device__ __forceinline__ void rms_row_to_bf16(const float* xrow, const float* g, bf16* orow, int lane) {
    const f32x4* xr = (const f32x4*)xrow + lane; const f32x4* gr = (const f32x4*)g + lane;
    f32x4 v[4]; float s = 0.f;
#pragma unroll
    for (int j = 0; j < 4; ++j) { v[j] = xr[64 * j]; s += (v[j][0] * v[j][0] + v[j][1] * v[j][1]) + (v[j][2] * v[j][2] + v[j][3] * v[j][3]); }
    const float r = rsqrtf(wave_sum(s) * (1.f / 1024.f) + EPS);
    u32x2* o8 = (u32x2*)orow + lane;
#pragma unroll
    for (int j = 0; j < 4; ++j) { const f32x4 gg = gr[64 * j]; u32x2 w; w.x = pk2(v[j][0] * r * gg[0], v[j][1] * r * gg[1]); w.y = pk2(v[j][2] * r * gg[2], v[j][3] * r * gg[3]); o8[64 * j] = w; }
}
__device__ __forceinline__ void rms_row_f32(float* xrow, const float* g, int lane) {
    f32x4* xr = (f32x4*)xrow + lane; const f32x4* gr = (const f32x4*)g + lane;
    f32x4 v[4]; float s = 0.f;
#pragma unroll
    for (int j = 0; j < 4; ++j) { v[j] = xr[64 * j]; s += (v[j][0] * v[j][0] + v[j][1] * v[j][1]) + (v[j][2] * v[j][2] + v[j][3] * v[j][3]); }
    const float r = rsqrtf(wave_sum(s) * (1.f / 1024.f) + EPS);
#pragma unroll
    for (int j = 0; j < 4; ++j) xr[64 * j] = v[j] * r * gr[64 * j];
}

__device__ __forceinline__ void cpow_table(float rho, float theta, int k, float& pr, float& pi) {
    const float mag = __expf(rho * (float)k);
    const double ang = (double)theta * (double)k; const double tw = 6.283185307179586476925286766559;
    const float red = (float)(ang - tw * __builtin_rint(ang / tw));
    pr = mag * cosf(red); pi = mag * sinf(red);
}
__device__ __forceinline__ void s5_tables_item(int item, LAS float* L, const float* a_re, const float* a_im, const float* log_dt, const float* b_re, const float* b_im,
                                               const float* c_re, const float* c_im, const float* dskip, bf16* Tg, bf16* Wg, float* L16, int tid) {
    const int g = item >> 4, k = item & 15;
    LAS float* Lkr = L; LAS float* Lki = L + 64; LAS float* L1r = L + 128; LAS float* L1i = L + 192; LAS float* cfr = L + 256; LAS float* cfi = L + 320;
    LAS float* Bbr = L + 384; LAS float* Bbi = Bbr + 1024; LAS float* Cr = Bbi + 1024; LAS float* Ci = Cr + 1024; LAS float* Kk = Ci + 1024;
    if (tid < 64) { const int n = tid; const float are = a_re[g * 64 + n], aim = a_im[g * 64 + n], dt = expf(log_dt[g]);
        const float rho = are * dt, theta = aim * dt;
        float lr, li; cpow_table(rho, theta, 1, lr, li);
        const float mag = expf(rho); const float sh = sinf(0.5f * theta);
        const float nr = expm1f(rho) * cosf(theta) - 2.0f * sh * sh, ni = li; (void)mag; (void)lr;
        const float den = are * are + aim * aim;
        cfr[n] = (nr * are + ni * aim) / den; cfi[n] = (ni * are - nr * aim) / den;
        float pr, pi; cpow_table(rho, theta, k, pr, pi); Lkr[n] = pr; Lki[n] = pi;
        cpow_table(rho, theta, k + 1, pr, pi); L1r[n] = pr; L1i[n] = pi;
        if (k == 15) { L16[g * 128 + n] = pr; L16[g * 128 + 64 + n] = pi; }
    }
    for (int e = tid; e < 1024; e += NTHR) { Cr[e] = c_re[g * 1024 + e]; Ci[e] = c_im[g * 1024 + e]; }
    __syncthreads();
    for (int e = tid; e < 1024; e += NTHR) { const int n = e >> 4; const float br = b_re[g * 1024 + e], bi = b_im[g * 1024 + e];
        Bbr[e] = cfr[n] * br - cfi[n] * bi; Bbi[e] = cfr[n] * bi + cfi[n] * br; }
    __syncthreads();
    if (tid < 256) { const int ho = tid >> 4, hi = tid & 15; float s = 0.f;
        for (int n = 0; n < 64; ++n) { const float clr = Cr[ho * 64 + n] * Lkr[n] - Ci[ho * 64 + n] * Lki[n], cli = Cr[ho * 64 + n] * Lki[n] + Ci[ho * 64 + n] * Lkr[n];
            s += clr * Bbr[n * 16 + hi] - cli * Bbi[n * 16 + hi]; }
        if (k == 0 && ho == hi) s += dskip[g * 16 + ho];
        Kk[tid] = s; }
    __syncthreads();
    bf16* Tgg = Tg + (size_t)g * 256 * AEXT_LD;
    {
        const int bi = tid >> 5, ho = (tid & 31) >> 1, h8 = (tid & 1) * 8;
        if (bi >= k) { const int to = bi, ti = bi - k; const LAS float* s = Kk + ho * 16 + h8;
            u32x4 w; w.x = pk2(s[0], s[1]); w.y = pk2(s[2], s[3]); w.z = pk2(s[4], s[5]); w.w = pk2(s[6], s[7]);
            *(u32x4*)(Tgg + (size_t)(to * 16 + ho) * AEXT_LD + ti * 16 + h8) = w; }
        if (k >= 1 && bi + k <= 15) { const int to = bi, ti = bi + k; *(u32x4*)(Tgg + (size_t)(to * 16 + ho) * AEXT_LD + ti * 16 + h8) = (u32x4){0u, 0u, 0u, 0u}; }
    }
    for (int e = tid; e < 1024; e += NTHR) { const int ho = e >> 6, n = e & 63;
        const float vr = Cr[e] * L1r[n] - Ci[e] * L1i[n], vi = Cr[e] * L1i[n] + Ci[e] * L1r[n];
        bf16* rowp = Tgg + (size_t)(k * 16 + ho) * AEXT_LD + 256;
        rowp[n] = (bf16)f2bf(vr); rowp[64 + n] = (bf16)f2bf(-vi); }
    {
        const int np = tid >> 1, h8 = (tid & 1) * 8, ti = 15 - k; float v[8];
#pragma unroll
        for (int x = 0; x < 8; ++x) { float val = 0.f;
            if (np < 128) { const int n = np & 63; const float br = Bbr[n * 16 + h8 + x], bi2 = Bbi[n * 16 + h8 + x];
                val = np < 64 ? (Lkr[n] * br - Lki[n] * bi2) : (Lkr[n] * bi2 + Lki[n] * br); }
            v[x] = val; }
        u32x4 w; w.x = pk2(v[0], v[1]); w.y = pk2(v[2], v[3]); w.z = pk2(v[4], v[5]); w.w = pk2(v[6], v[7]);
        *(u32x4*)(Wg + ((size_t)g * 256 + np) * 256 + ti * 16 + h8) = w;
    }
    __syncthreads();
}

__device__ __forceinline__ void s5_scan_item(int item, LAS float* L, const float* Sloc, const float* L16, bf16* Aext, int tid) {
    const int g = item >> 3, b = item & 7, seg = tid >> 6, n = tid & 63;
    const float ar = L16[g * 128 + n], ai = L16[g * 128 + 64 + n];
    const float* sl = Sloc + (size_t)(g * 2048 + b * 256 + seg * 32) * 128 + n;
    float er = 0.f, ei = 0.f;
#pragma unroll 8
    for (int c = 0; c < 32; ++c) { const float sr = sl[c * 128], si = sl[c * 128 + 64]; const float t = ar * er - ai * ei + sr; ei = ar * ei + ai * er + si; er = t; }
    float pr = ar, pi = ai;
#pragma unroll
    for (int i = 0; i < 5; ++i) { const float t = pr * pr - pi * pi; pi = 2.f * pr * pi; pr = t; }
    L[(seg * 64 + n) * 2] = er; L[(seg * 64 + n) * 2 + 1] = ei;
    __syncthreads();
    float xr = 0.f, xi = 0.f;
    for (int s = 0; s < seg; ++s) { const float qr = L[(s * 64 + n) * 2], qi = L[(s * 64 + n) * 2 + 1]; const float t = pr * xr - pi * xi + qr; xi = pr * xi + pi * xr + qi; xr = t; }
    bf16* dst = Aext + (size_t)(g * 2048 + b * 256 + seg * 32) * AEXT_LD + 256 + n;
#pragma unroll 8
    for (int c = 0; c < 32; ++c) { const float sr = sl[c * 128], si = sl[c * 128 + 64];
        dst[c * AEXT_LD] = (bf16)f2bf(xr); dst[c * AEXT_LD + 64] = (bf16)f2bf(xi);
        const float t = ar * xr - ai * xi + sr; xi = ar * xi + ai * xr + si; xr = t; }
    __syncthreads();
}

constexpr int RP = 72;
template <bool FULL>
__device__ __forceinline__ void retention_item(int item, LAS unsigned char* lds, const bf16* Q, const bf16* Kb, const bf16* V, const bf16* SGR, float* KVseg, bf16* Ymix, int tid) {
    const int b = item >> 5, h = (item >> 2) & 7, seg = item & 3;
    const int wid = tid >> 6, lane = tid & 63, l15 = lane & 15, q4 = lane >> 4;
    LAS bf16* Qs = (LAS bf16*)lds; LAS bf16* Ks = Qs + 64 * RP; LAS bf16* KTs = Ks + 64 * RP; LAS bf16* VTs = KTs + 64 * RP;
    LAS bf16* Ps = VTs + 128 * RP; LAS bf16* STs = Ps + 64 * RP; LAS float* stat = (LAS float*)(STs + 128 * RP);
    const float lg2 = log2f(1.0f - exp2f(-5.0f - (float)h));
    const float d64 = exp2f(lg2 * 64.0f);
    const int db = wid >> 1, et0 = (wid & 1) * 4;
    f32x4 Sacc[4];
#pragma unroll
    for (int t = 0; t < 4; ++t) Sacc[t] = (f32x4){0.f, 0.f, 0.f, 0.f};
    if (FULL) {
        const float w1024 = exp2f(lg2 * 1024.0f); float wgt = 1.0f;
        for (int s = seg - 1; s >= 0; --s) { const float* kv = KVseg + (size_t)((b * 8 + h) * 4 + s) * 8192;
#pragma unroll
            for (int t = 0; t < 4; ++t)
#pragma unroll
                for (int r = 0; r < 4; ++r) Sacc[t][r] += wgt * kv[(db * 16 + 4 * q4 + r) * 128 + (et0 + t) * 16 + l15];
            wgt *= w1024; }
#pragma unroll
        for (int t = 0; t < 4; ++t) { u32x2 w; w.x = pk2(Sacc[t][0], Sacc[t][1]); w.y = pk2(Sacc[t][2], Sacc[t][3]); *(LAS u32x2*)(STs + ((et0 + t) * 16 + l15) * RP + db * 16 + 4 * q4) = w; }
    }
    const int tok_seg = b * SEQ + seg * 1024;
    for (int ch = 0; ch < 16; ++ch) {
        const int tok0 = tok_seg + ch * 64;
        {
            const int row = tid >> 3, cp = tid & 7;
            const u32x4 kw = *(const u32x4*)(Kb + (size_t)(tok0 + row) * 512 + h * 64 + cp * 8);
            u32x4 qw; if (FULL) qw = *(const u32x4*)(Q + (size_t)(tok0 + row) * 512 + h * 64 + cp * 8);
            u32x4 vw[2];
#pragma unroll
            for (int i = 0; i < 2; ++i) { const int p = tid + 512 * i; vw[i] = *(const u32x4*)(V + (size_t)(tok0 + (p >> 4)) * 1024 + h * 128 + (p & 15) * 8); }
            if (FULL) { *(LAS u32x4*)(Ks + row * RP + cp * 8) = kw; *(LAS u32x4*)(Qs + row * RP + cp * 8) = qw; }
            const float kd = exp2f(lg2 * (float)(63 - row));
            f32x4 k0, k1; unpack8(kw, k0, k1);
#pragma unroll
            for (int x = 0; x < 4; ++x) { KTs[(cp * 8 + x) * RP + row] = (bf16)f2bf(k0[x] * kd); KTs[(cp * 8 + 4 + x) * RP + row] = (bf16)f2bf(k1[x] * kd); }
#pragma unroll
            for (int i = 0; i < 2; ++i) { const int p = tid + 512 * i, vr = p >> 4, vc = (p & 15) * 8; const unsigned ww[4] = {vw[i].x, vw[i].y, vw[i].z, vw[i].w};
#pragma unroll
                for (int x = 0; x < 4; ++x) { VTs[(vc + 2 * x) * RP + vr] = (bf16)(ww[x] & 0xffffu); VTs[(vc + 2 * x + 1) * RP + vr] = (bf16)(ww[x] >> 16); } }
        }
        __syncthreads();
        f32x4 oacc[4], cacc[4];
        if (FULL) {
            const int ib = wid >> 1;
#pragma unroll
            for (int jj = 0; jj < 2; ++jj) { const int jb = (wid & 1) * 2 + jj; f32x4 sacc = (f32x4){0.f, 0.f, 0.f, 0.f};
#pragma unroll
                for (int ks = 0; ks < 2; ++ks) { const bf16x8 af = *(const LAS bf16x8*)(Ks + (jb * 16 + l15) * RP + ks * 32 + 8 * q4); const bf16x8 bfr = *(const LAS bf16x8*)(Qs + (ib * 16 + l15) * RP + ks * 32 + 8 * q4);
                    sacc = __builtin_amdgcn_mfma_f32_16x16x32_bf16(af, bfr, sacc, 0, 0, 0); }
                const int i = ib * 16 + l15, j0 = jb * 16 + 4 * q4; float pv[4];
#pragma unroll
                for (int r = 0; r < 4; ++r) { const int dist = i - (j0 + r); pv[r] = sacc[r] * exp2f(lg2 * (float)(dist < 0 ? -dist : dist)); }
                u32x2 w; w.x = pk2(pv[0], pv[1]); w.y = pk2(pv[2], pv[3]); *(LAS u32x2*)(Ps + i * RP + j0) = w; }
            __syncthreads();
#pragma unroll
            for (int t = 0; t < 4; ++t) { oacc[t] = (f32x4){0.f, 0.f, 0.f, 0.f}; cacc[t] = (f32x4){0.f, 0.f, 0.f, 0.f}; }
#pragma unroll
            for (int ks = 0; ks < 2; ++ks) { const bf16x8 pa = *(const LAS bf16x8*)(Ps + (ib * 16 + l15) * RP + ks * 32 + 8 * q4); const bf16x8 qa = *(const LAS bf16x8*)(Qs + (ib * 16 + l15) * RP + ks * 32 + 8 * q4);
#pragma unroll
                for (int t = 0; t < 4; ++t) { const bf16x8 vb = *(const LAS bf16x8*)(VTs + ((et0 + t) * 16 + l15) * RP + ks * 32 + 8 * q4); const bf16x8 sb = *(const LAS bf16x8*)(STs + ((et0 + t) * 16 + l15) * RP + ks * 32 + 8 * q4);
                    oacc[t] = __builtin_amdgcn_mfma_f32_16x16x32_bf16(pa, vb, oacc[t], 0, 0, 0); cacc[t] = __builtin_amdgcn_mfma_f32_16x16x32_bf16(qa, sb, cacc[t], 0, 0, 0); } }
#pragma unroll
            for (int r = 0; r < 4; ++r) { const int i = ib * 16 + 4 * q4 + r; const float qd = exp2f(lg2 * (float)(i + 1)); float s = 0.f, sq = 0.f;
#pragma unroll
                for (int t = 0; t < 4; ++t) { const float o = oacc[t][r] + qd * cacc[t][r]; oacc[t][r] = o; s += o; sq += o * o; }
#pragma unroll
                for (int o = 1; o < 16; o <<= 1) { s += __shfl_xor(s, o); sq += __shfl_xor(sq, o); }
                if (l15 == 0) { stat[i * 4 + (wid & 1) * 2] = s; stat[i * 4 + (wid & 1) * 2 + 1] = sq; } }
            __syncthreads();
#pragma unroll
            for (int r = 0; r < 4; ++r) { const int i = ib * 16 + 4 * q4 + r; const f32x4 st = *(const LAS f32x4*)(stat + i * 4);
                const float mean = (st[0] + st[2]) * (1.f / 128.f); const float var = (st[1] + st[3]) * (1.f / 128.f) - mean * mean; const float rstd = rsqrtf(fmaxf(var, 0.f) + EPS);
                const size_t tok = (size_t)(tok0 + i);
#pragma unroll
                for (int t = 0; t < 4; ++t) { const int e = (et0 + t) * 16 + l15; const float gte = bf2f(SGR[tok * 1024 + h * 128 + e]);
                    Ymix[tok * 2048 + 1024 + h * 128 + e] = (bf16)f2bf((oacc[t][r] - mean) * rstd * gte); } }
        }
#pragma unroll
        for (int t = 0; t < 4; ++t) Sacc[t] = Sacc[t] * d64;
#pragma unroll
        for (int ks = 0; ks < 2; ++ks) { const bf16x8 ka = *(const LAS bf16x8*)(KTs + (db * 16 + l15) * RP + ks * 32 + 8 * q4);
#pragma unroll
            for (int t = 0; t < 4; ++t) { const bf16x8 vb = *(const LAS bf16x8*)(VTs + ((et0 + t) * 16 + l15) * RP + ks * 32 + 8 * q4); Sacc[t] = __builtin_amdgcn_mfma_f32_16x16x32_bf16(ka, vb, Sacc[t], 0, 0, 0); } }
        if (FULL) {
#pragma unroll
            for (int t = 0; t < 4; ++t) { u32x2 w; w.x = pk2(Sacc[t][0], Sacc[t][1]); w.y = pk2(Sacc[t][2], Sacc[t][3]); *(LAS u32x2*)(STs + ((et0 + t) * 16 + l15) * RP + db * 16 + 4 * q4) = w; }
        }
        __syncthreads();
    }
    if (!FULL) { float* kv = KVseg + (size_t)item * 8192;
#pragma unroll
        for (int t = 0; t < 4; ++t)
#pragma unroll
            for (int r = 0; r < 4; ++r) kv[(db * 16 + 4 * q4 + r) * 128 + (et0 + t) * 16 + l15] = Sacc[t][r]; }
}

__device__ __forceinline__ void conv_item(int item, LAS unsigned char* lds, const bf16* U2, const bf16* SG2, const float* cw, const float* cb, const float* lng, const float* lnb, bf16* V2, int tid) {
    const int b = item >> 7, l0 = (item & 127) * 32, c0 = 2 * tid;
    LAS float* T = (LAS float*)lds;
    {
        f32x2 w[31];
        const char* cwb = (const char*)cw; const unsigned coff = (unsigned)c0 * 4u;
#pragma unroll
        for (int k = 0; k < 31; ++k) w[k] = *(const f32x2*)(cwb + (coff + (unsigned)k * 4096u));
        const f32x2 bias = *(const f32x2*)(cb + c0);
        const char* ub = (const char*)U2;
#pragma unroll 1
        for (int hf = 0; hf < 2; ++hf) {
            f32x2 u[46]; const int lb = l0 - 30 + hf * 16;
#pragma unroll
            for (int j = 0; j < 46; ++j) { const int l = lb + j; unsigned uw = 0u;
                if (l >= 0) uw = *(const unsigned*)(ub + ((unsigned)(b * SEQ + l) * 2048u + (unsigned)c0 * 2u));
                u[j][0] = bf2f(uw & 0xffffu); u[j][1] = bf2f(uw >> 16); }
#pragma unroll
            for (int t = 0; t < 16; ++t) { f32x2 a = bias;
#pragma unroll
                for (int k = 0; k < 31; ++k) a += w[k] * u[t + k];
                *(LAS f32x2*)(T + (hf * 16 + t) * 1024 + c0) = a; }
        }
    }
    __syncthreads();
    const int wid = tid >> 6, lane = tid & 63;
#pragma unroll
    for (int tt = 0; tt < 4; ++tt) { const int t = wid * 4 + tt; const size_t tok = (size_t)(b * SEQ + l0 + t);
        f32x4 v[4]; float s = 0.f;
#pragma unroll
        for (int q = 0; q < 4; ++q) { v[q] = *(const LAS f32x4*)(T + t * 1024 + lane * 4 + 256 * q); s += (v[q][0] + v[q][1]) + (v[q][2] + v[q][3]); }
        const float mean = wave_sum(s) * (1.f / 1024.f); float s2 = 0.f;
#pragma unroll
        for (int q = 0; q < 4; ++q) { v[q] = v[q] - mean; s2 += (v[q][0] * v[q][0] + v[q][1] * v[q][1]) + (v[q][2] * v[q][2] + v[q][3] * v[q][3]); }
        const float rstd = rsqrtf(wave_sum(s2) * (1.f / 1024.f) + EPS);
#pragma unroll
        for (int q = 0; q < 4; ++q) { const int c = lane * 4 + 256 * q; const f32x4 gg = *(const f32x4*)(lng + c), bb = *(const f32x4*)(lnb + c);
            const u32x2 gw = *(const u32x2*)(SG2 + tok * 1024 + c); float o[4];
            const float gt[4] = {bf2f(gw.x & 0xffffu), bf2f(gw.x >> 16), bf2f(gw.y & 0xffffu), bf2f(gw.y >> 16)};
#pragma unroll
            for (int i = 0; i < 4; ++i) o[i] = fsilu(v[q][i] * rstd * gg[i] + bb[i]) * gt[i];
            u32x2 w; w.x = pk2(o[0], o[1]); w.y = pk2(o[2], o[3]); *(u32x2*)(V2 + tok * 1024 + c) = w; } }
    __syncthreads();
}

#ifndef MK_PER_PHASE
#define MK_PER_PHASE 1
#endif
constexpr int N_PHASES = 11;
struct Args { const float* in[21]; float* out; unsigned char* ws; int ph_lo, ph_hi; };

__global__ void __launch_bounds__(NTHR, 2) fwd_megakernel(Args args) {
    extern __shared__ __attribute__((aligned(16))) unsigned char lds_raw[];
    LAS unsigned char* lds = (LAS unsigned char*)lds_raw;
    const int tid = threadIdx.x, lane = tid & 63, wave = __builtin_amdgcn_readfirstlane(tid >> 6);
    const int G = gridDim.x, bid = blockIdx.x;
    const int gw = bid * NWAVES + wave, NGW = G * NWAVES;
    unsigned char* ws = args.ws;
    const float* x = args.in[0]; const float* norm_g = args.in[1]; const float* final_g = args.in[2]; const float* w_in_ab = args.in[3];
    const float* s5_a_re = args.in[4]; const float* s5_a_im = args.in[5]; const float* s5_log_dt = args.in[6]; const float* s5_b_re = args.in[7]; const float* s5_b_im = args.in[8];
    const float* s5_c_re = args.in[9]; const float* s5_c_im = args.in[10]; const float* s5_d = args.in[11]; const float* s5_glu_w = args.in[12]; const float* s5_glu_b = args.in[13];
    const float* w_out_ab = args.in[14]; const float* w_in_c = args.in[15]; const float* conv_w = args.in[16]; const float* conv_b = args.in[17];
    const float* conv_ln_g = args.in[18]; const float* conv_ln_b = args.in[19]; const float* w_out_c = args.in[20];
    float* out = args.out;
    float* ss1 = (float*)(ws + WS_CTL);
    float* ropec = (float*)(ws + WS_ROPE); float* ropes = ropec + 4096 * 32;
    bf16* WinT = (bf16*)(ws + WS_WIN); bf16* WgluT = (bf16*)(ws + WS_WGLU); bf16* WoutT = (bf16*)(ws + WS_WOUT); bf16* WincT = (bf16*)(ws + WS_WINC); bf16* WoutcT = (bf16*)(ws + WS_WOUTC);
    bf16* Tg = (bf16*)(ws + WS_TG); bf16* Wg = (bf16*)(ws + WS_WG); float* L16 = (float*)(ws + WS_L16); float* KVseg = (float*)(ws + WS_KVSEG);
    bf16* XN = (bf16*)(ws + WS_XN); float* Sloc = (float*)(ws + WS_XN); bf16* Yg = (bf16*)(ws + WS_XN); bf16* XG2 = (bf16*)(ws + WS_XN);
    bf16* Aext = (bf16*)(ws + WS_AEXT); bf16* SG5 = (bf16*)(ws + WS_SG5); bf16* Qb = (bf16*)(ws + WS_Q); bf16* Kb = (bf16*)(ws + WS_K); bf16* Vb = (bf16*)(ws + WS_V); bf16* SGR = (bf16*)(ws + WS_SGR);
    float* X1 = (float*)(ws + WS_X1); bf16* U2 = (bf16*)(ws + WS_U2); bf16* SG2 = (bf16*)(ws + WS_SG2); bf16* V2 = (bf16*)(ws + WS_V2);
    bf16* Ymix = (bf16*)out;

    const int lo = args.ph_lo, hi = args.ph_hi;
#define IN(k) (lo <= (k) && (k) < hi)
#define SEAM(k) do { if (IN(k) && IN((k) + 1)) { cg::this_grid().sync(); } } while (0)

    if (IN(0)) {
        LAS float* scr = (LAS float*)(lds + wave * 16384);
        constexpr int I_IN = 16 * 160, I_GLU = 16 * 32, I_OUT = 32 * 32, I_INC = 16 * 96, I_OUTC = 16 * 32;
        constexpr int NITEMS = I_IN + I_GLU + I_OUT + I_INC + I_OUTC;
        for (int it = gw; it < NITEMS; it += NGW) {
            int r = it;
            if (r < I_IN) { p0_transpose_item(w_in_ab, 1024, 5120, WinT, 1, scr, r, lane); continue; } r -= I_IN;
            if (r < I_GLU) { p0_transpose_item(s5_glu_w, 1024, 1024, WgluT, 0, scr, r, lane); continue; } r -= I_GLU;
            if (r < I_OUT) { p0_transpose_item(w_out_ab, 2048, 1024, WoutT, 0, scr, r, lane); continue; } r -= I_OUT;
            if (r < I_INC) { p0_transpose_item(w_in_c, 1024, 3072, WincT, 2, scr, r, lane); continue; } r -= I_INC;
            p0_transpose_item(w_out_c, 1024, 1024, WoutcT, 0, scr, r, lane);
        }
        for (int e = bid * NTHR + tid; e < 4096 * 32; e += G * NTHR) { const int pos = e >> 5, f = e & 31;
            const double freq = exp(-(double)f * (9.210340371976182736 / 32.0)); const double ang = (double)pos * freq; const double tw = 6.283185307179586476925286766559;
            const float red = (float)(ang - tw * __builtin_rint(ang / tw)); ropec[e] = cosf(red); ropes[e] = sinf(red); }
        __syncthreads();
        for (int it = bid; it < 1024; it += G) s5_tables_item(it, (LAS float*)lds, s5_a_re, s5_a_im, s5_log_dt, s5_b_re, s5_b_im, s5_c_re, s5_c_im, s5_d, Tg, Wg, L16, tid);
        for (int m = gw; m < M; m += NGW) rms_row_to_bf16(x + (size_t)m * DM, norm_g, XN + (size_t)m * DM, lane);
    }
    SEAM(0);
    if (IN(1)) {
        pg8::Gemm g{XN, WinT, 1024, 1024, 1024, 0, 0}; pg8::StaticOrder S; S.init(M, 5120, G, bid);
        EpiWin E{Aext, SG5, Qb, Kb, Vb, SGR, ropec, ropes};
        pg8::gemm_phase<EpiWin, pg8::StaticOrder, true, false>(lds, g, S, E);
    }
    SEAM(1);
    if (IN(2)) {
        pg8::Gemm g{Aext, Wg, 256, AEXT_LD, 256, 0, 0}; pg8::GroupOrder S{G, bid};
        EpiSloc E{Sloc};
        pg8::gemm_phase<EpiSloc, pg8::GroupOrder, true, true>(lds, g, S, E);
        for (int it = bid; it < 256; it += G) { if ((it & 3) != 3) retention_item<false>(it, lds, Qb, Kb, Vb, SGR, KVseg, Ymix, tid); }
    }
    SEAM(2);
    if (IN(3)) { for (int it = bid; it < 512; it += G) s5_scan_item(it, (LAS float*)lds, Sloc, L16, Aext, tid); }
    SEAM(3);
    if (IN(4)) {
        pg8::Gemm g{Aext, Tg, AEXT_LD, AEXT_LD, AEXT_LD, 0, 0}; pg8::GroupOrder S{G, bid};
        EpiYg E{Yg};
        pg8::gemm_phase<EpiYg, pg8::GroupOrder, true, false>(lds, g, S, E);
        for (int it = bid; it < 256; it += G) retention_item<true>(it, lds, Qb, Kb, Vb, SGR, KVseg, Ymix, tid);
    }
    SEAM(4);
    if (IN(5)) {
        pg8::Gemm g{Yg, WgluT, 1024, 0, 1024, 1, M}; pg8::StaticOrder S; S.init(M, 1024, G, bid);
        EpiGlu E{Yg, SG5, s5_glu_b, Ymix};
        pg8::gemm_phase<EpiGlu, pg8::StaticOrder, true, false>(lds, g, S, E);
    }
    SEAM(5);
    if (IN(6)) {
        pg8::Gemm g{Ymix, WoutT, 2048, 2048, 2048, 0, 0}; pg8::StaticOrder S; S.init(M, 1024, G, bid);
        EpiWout E{x, X1, XG2, norm_g + 1024, ss1};
        pg8::gemm_phase<EpiWout, pg8::StaticOrder, true, false>(lds, g, S, E);
    }
    SEAM(6);
    if (IN(7)) {
        pg8::Gemm g{XG2, WincT, 1024, 1024, 1024, 0, 0}; pg8::StaticOrder S; S.init(M, 3072, G, bid);
        EpiWinC E{ss1, U2, SG2};
        pg8::gemm_phase<EpiWinC, pg8::StaticOrder, true, false>(lds, g, S, E);
    }
    SEAM(7);
    if (IN(8)) { for (int it = bid; it < 1024; it += G) conv_item(it, lds, U2, SG2, conv_w, conv_b, conv_ln_g, conv_ln_b, V2, tid); }
    SEAM(8);
    if (IN(9)) {
        pg8::Gemm g{V2, WoutcT, 1024, 1024, 1024, 0, 0}; pg8::StaticOrder S; S.init(M, 1024, G, bid);
        EpiWoutC E{X1, out};
        pg8::gemm_phase<EpiWoutC, pg8::StaticOrder, true, false>(lds, g, S, E);
    }
    SEAM(9);
    if (IN(10)) { for (int m = gw; m < M; m += NGW) rms_row_f32(out + (size_t)m * DM, final_g, lane); }
#undef IN
#undef SEAM
}

extern "C" void kernel_launch(void* const* d_in, const int* in_sizes, int n_in, void* d_out, int out_size, void* d_ws, size_t ws_size, hipStream_t stream) {
    static int grid = 0;
    if (grid == 0) {
        if (n_in != 21 || out_size != M * DM || ws_size < WS_END) { fprintf(stderr, "kernel_launch: unexpected shapes (n_in %d, out %d, ws %zu)\n", n_in, out_size, ws_size); grid = -1; return; }
        int dev = 0, cus = 0, per_cu = 0;
        if (hipGetDevice(&dev) != hipSuccess || hipDeviceGetAttribute(&cus, hipDeviceAttributeMultiprocessorCount, dev) != hipSuccess) { grid = -1; return; }
        if (hipFuncSetAttribute((const void*)fwd_megakernel, hipFuncAttributeMaxDynamicSharedMemorySize, LDS_BYTES) != hipSuccess) { fprintf(stderr, "kernel_launch: hipFuncSetAttribute failed\n"); grid = -1; return; }
        if (hipOccupancyMaxActiveBlocksPerMultiprocessor(&per_cu, (const void*)fwd_megakernel, NTHR, LDS_BYTES) != hipSuccess || per_cu < 1) { fprintf(stderr, "kernel_launch: occupancy query says %d\n", per_cu); per_cu = 1; }
        (void)hipGetLastError();
        grid = cus;
    }
    if (grid < 0) return;
    (void)hipMemsetAsync((char*)d_ws + WS_CTL, 0, CTL_ZERO_BYTES, stream);
    Args a{};
    for (int i = 0; i < 21; ++i) a.in[i] = (const float*)d_in[i];
    a.out = (float*)d_out; a.ws = (unsigned char*)d_ws;
#if MK_PER_PHASE
    for (int p = 0; p < N_PHASES; ++p) { a.ph_lo = p; a.ph_hi = p + 1; hipLaunchKernelGGL(fwd_megakernel, dim3(grid), dim3(NTHR), LDS_BYTES, stream, a); }
#else
    a.ph_lo = 0; a.ph_hi = N_PHASES;
    void* kargs[] = {&a};
    hipError_t e = hipLaunchCooperativeKernel((const void*)fwd_megakernel, dim3(grid), dim3(NTHR), kargs, LDS_BYTES, stream);
    if (e != hipSuccess) fprintf(stderr, "kernel_launch: cooperative launch failed: %s (grid %d)\n", hipGetErrorString(e), grid);
#endif
}
```

```cpp
#include <hip/hip_runtime.h>
#include <hip/hip_cooperative_groups.h>
#include <cstdio>
#include <cstdint>
namespace cg = cooperative_groups;

namespace pg8 {
#define PG8_LAS __attribute__((address_space(3)))
typedef unsigned short bf16_t;
typedef short bf16x8 __attribute__((ext_vector_type(8)));
typedef float f32x4 __attribute__((ext_vector_type(4)));
typedef float f32x2 __attribute__((ext_vector_type(2)));
typedef unsigned u32x4 __attribute__((ext_vector_type(4)));
typedef unsigned u32x2 __attribute__((ext_vector_type(2)));
constexpr int BM = 256, BK = 64, HALF = 128, HTB = HALF * BK * 2  , STAGE_BYTES = 8 * HTB, NXCD = 8, WGM = 8;

__host__ __device__ __forceinline__ int lds_byte(int r, int c) { const int st = (r >> 4) * 2 + (c >> 5), rr = r & 15, cc = c & 31, ob = rr * 64 + cc * 2; return st * 1024 + (ob ^ (((ob >> 9) & 1) << 5)); }
__host__ __device__ __forceinline__ void stage_rc(int b, int& R, int& C) { const int st = b / 1024, sb = b % 1024, swz = sb ^ (((sb >> 9) & 1) << 5); R = (st >> 1) * 16 + swz / 64; C = (st & 1) * 32 + (swz % 64) / 2; }
__host__ __device__ __forceinline__ int perm32(int rho) { const int n = rho >> 4, i = rho & 15; return 8 * (i >> 2) + 4 * n + (i & 3); }

struct Unit { int pm, pn; };
struct Gemm { const bf16_t* A; const bf16_t* Bt; int K, lda, ldb, amode, gM; };

struct StaticOrder {
    int nM, nN, nwg, G, c;
    __host__ __device__ void init(int M, int N, int G_, int c_) { nM = M / BM; nN = N / BM; nwg = nM * nN; G = G_; c = c_; }
    __host__ __device__ bool next(int i, Unit& u) const {
        const long L = (long)i * G + c; if (L >= nwg) return false;
        int wgid = (int)L; { const int q = nwg / NXCD, r = nwg % NXCD, xcd = wgid % NXCD, off = wgid / NXCD; wgid = (xcd < r ? xcd * (q + 1) : r * (q + 1) + (xcd - r) * q) + off; }
        const int nig = WGM * nN, gid = wgid / nig, fm = gid * WGM, gsz = (nM - fm) < WGM ? (nM - fm) : WGM;
        u.pm = fm + ((wgid % nig) % gsz); u.pn = (wgid % nig) / gsz; return true;
    }
};
struct GroupOrder {
    int G, c;
    __host__ __device__ bool next(int i, Unit& u) const { const int L = i * G + c; if (L >= 512) return false; u.pm = L; u.pn = L >> 3; return true; }
};

__device__ __forceinline__ unsigned cvt_pk_bf16(float lo, float hi) { unsigned r; asm volatile("v_cvt_pk_bf16_f32 %0, %1, %2" : "=v"(r) : "v"(lo), "v"(hi)); return r; }

template <class Epi, class Sched, bool ALIGN_EPI, bool SKIPB1>
__device__ __forceinline__ void gemm_phase(PG8_LAS unsigned char* lds, const Gemm g, const Sched& S, const Epi& E) {
    const int tid = threadIdx.x, wid = __builtin_amdgcn_readfirstlane(tid >> 6), lane = tid & 63, wr = wid >> 2, wc = wid & 3, fr = lane & 15, fq = lane >> 4;
    const int K = g.K, nt = K / BK;
    unsigned voffA[2], voffB[2];
#pragma unroll
    for (int i = 0; i < 2; ++i) { int R, C; stage_rc(tid * 16 + i * 8192, R, C); const int Rb = Epi::PERM ? ((R & ~31) + perm32(R & 31)) : R;
        voffA[i] = g.amode ? (unsigned)(((C >> 4) * g.gM + R) * 16 + (C & 15)) * 2u : (unsigned)(R * g.lda + C) * 2u;
        voffB[i] = (unsigned)(Rb * g.ldb + C) * 2u; }
    const size_t kstepA = g.amode ? (size_t)g.gM * 128 : (size_t)(BK * 2);
    const size_t kstepB = (size_t)(BK * 2);
    const size_t hstepA = g.amode ? (size_t)HALF * 32 : (size_t)HALF * g.lda * 2;
    const size_t hstepB = (size_t)HALF * g.ldb * 2;
    const size_t tstepA = 2 * hstepA, tstepB = 2 * hstepB;
    const unsigned ldsw = (unsigned)wid * 1024u;
    const int aoff = lds_byte(wr * 64 + fr, fq * 8), boff = lds_byte(wc * 32 + fr, fq * 8);
#define PG8_SA(b, h) (((b) * 2 + (h)) * HTB)
#define PG8_SB(b, h) ((4 + (b) * 2 + (h)) * HTB)
#define PG8_STAGE(bufoff, gbase, voff) do { _Pragma("unroll") for (int _i = 0; _i < 2; ++_i) \
        __builtin_amdgcn_global_load_lds((const unsigned*)((const char*)(gbase) + (voff)[_i]), (PG8_LAS unsigned*)(lds + (bufoff) + ldsw + _i * 8192), 16, 0, 0); } while (0)
#define PG8_LDA(dst, b, h) do { _Pragma("unroll") for (int m = 0; m < 4; ++m) _Pragma("unroll") for (int k = 0; k < 2; ++k) dst[m][k] = *(const PG8_LAS bf16x8*)(lds + PG8_SA(b, h) + aoff + m * 2048 + k * 1024); } while (0)
#define PG8_LDB(dst, b, h) do { _Pragma("unroll") for (int n = 0; n < 2; ++n) _Pragma("unroll") for (int k = 0; k < 2; ++k) dst[n][k] = *(const PG8_LAS bf16x8*)(lds + PG8_SB(b, h) + boff + n * 2048 + k * 1024); } while (0)
#define PG8_MMA(ai, bj, At, Bt) do { __builtin_amdgcn_s_setprio(1); _Pragma("unroll") for (int m = 0; m < 4; ++m) _Pragma("unroll") for (int n = 0; n < 2; ++n) _Pragma("unroll") for (int k = 0; k < 2; ++k) \
        acc[ai][bj][m][n] = __builtin_amdgcn_mfma_f32_16x16x32_bf16(Bt[n][k], At[m][k], acc[ai][bj][m][n], 0, 0, 0); __builtin_amdgcn_s_setprio(0); } while (0)
#define PG8_MMA1(ai, At, Bt) do { if constexpr (!SKIPB1) PG8_MMA(ai, 1, At, Bt); } while (0)
#define PG8_WAIT_V(n) asm volatile("s_waitcnt vmcnt(" #n ")" ::: "memory")
#define PG8_WAIT_L(n) asm volatile("s_waitcnt lgkmcnt(" #n ")" ::: "memory")
#define PG8_BAR __builtin_amdgcn_s_barrier()
#define PG8_SCHED __builtin_amdgcn_sched_barrier(0)
    Unit cur, nxt; int ui = 0;
    if (!S.next(0, cur)) return;
    f32x4 acc[2][2][4][2];
#pragma unroll
    for (int a = 0; a < 2; ++a)
#pragma unroll
        for (int b = 0; b < 2; ++b)
#pragma unroll
            for (int m = 0; m < 4; ++m)
#pragma unroll
                for (int n = 0; n < 2; ++n) acc[a][b][m][n] = (f32x4){0.f, 0.f, 0.f, 0.f};
    bf16x8 At[4][2], B0[2][2], B1[2][2];
    const char* cA = (const char*)g.A + (size_t)cur.pm * tstepA; const char* cB = (const char*)g.Bt + (size_t)cur.pn * tstepB;
    PG8_STAGE(PG8_SB(0, 0), cB, voffB); PG8_STAGE(PG8_SB(0, 1), cB + hstepB, voffB); PG8_STAGE(PG8_SA(0, 0), cA, voffA); PG8_STAGE(PG8_SA(0, 1), cA + hstepA, voffA);
    if (wr == 1) PG8_BAR;
    PG8_WAIT_V(2); PG8_BAR;
    PG8_STAGE(PG8_SB(1, 0), cB + kstepB, voffB); PG8_STAGE(PG8_SA(1, 0), cA + kstepA, voffA); PG8_STAGE(PG8_SB(1, 1), cB + hstepB + kstepB, voffB);
    PG8_WAIT_V(6); PG8_BAR;
    for (;;) {
        const bool has_next = S.next(ui + 1, nxt);
        const char* nA = has_next ? (const char*)g.A + (size_t)nxt.pm * tstepA : cA; const char* nB = has_next ? (const char*)g.Bt + (size_t)nxt.pn * tstepB : cB;
        for (int t = 0; t < nt; t += 2) {
            const bool last = (t == nt - 2);
            const char* a1 = cA + (size_t)(t + 1) * kstepA;
            const char* a2 = last ? nA : cA + (size_t)(t + 2) * kstepA; const char* b2 = last ? nB : cB + (size_t)(t + 2) * kstepB;
            const char* a3 = a2 + kstepA; const char* b3 = b2 + kstepB;
            PG8_LDB(B0, 0, 0); PG8_LDB(B1, 0, 1); PG8_SCHED; PG8_LDA(At, 0, 0); PG8_STAGE(PG8_SA(1, 1), a1 + hstepA, voffA);
            PG8_WAIT_V(8); PG8_WAIT_L(0); PG8_BAR; PG8_MMA(0, 0, At, B0); PG8_MMA1(0, At, B1); PG8_BAR; PG8_SCHED;
            PG8_LDA(At, 0, 1); PG8_STAGE(PG8_SB(0, 0), b2, voffB); PG8_STAGE(PG8_SB(0, 1), b2 + hstepB, voffB); PG8_STAGE(PG8_SA(0, 0), a2, voffA);
            PG8_WAIT_V(8); PG8_WAIT_L(0); PG8_BAR; PG8_MMA(1, 0, At, B0); PG8_MMA1(1, At, B1); PG8_BAR; PG8_SCHED;
            PG8_LDB(B0, 1, 0); PG8_LDB(B1, 1, 1); PG8_SCHED; PG8_LDA(At, 1, 0); PG8_STAGE(PG8_SA(0, 1), a2 + hstepA, voffA);
            PG8_WAIT_V(8); PG8_WAIT_L(0); PG8_BAR; PG8_MMA(0, 0, At, B0); PG8_MMA1(0, At, B1); PG8_BAR; PG8_SCHED;
            PG8_LDA(At, 1, 1); PG8_STAGE(PG8_SB(1, 0), b3, voffB); PG8_STAGE(PG8_SB(1, 1), b3 + hstepB, voffB); PG8_STAGE(PG8_SA(1, 0), a3, voffA);
            PG8_WAIT_V(8); PG8_WAIT_L(0); PG8_BAR; PG8_MMA(1, 0, At, B0); PG8_MMA1(1, At, B1); PG8_BAR; PG8_SCHED;
        }
        if constexpr (ALIGN_EPI) { if (wr == 0) PG8_BAR; }
        E(acc, cur, wr, wc, fr, fq);
        if (!has_next) break;
#pragma unroll
        for (int a = 0; a < 2; ++a)
#pragma unroll
            for (int b = 0; b < 2; ++b)
#pragma unroll
                for (int m = 0; m < 4; ++m)
#pragma unroll
                    for (int n = 0; n < 2; ++n) acc[a][b][m][n] = (f32x4){0.f, 0.f, 0.f, 0.f};
        cur = nxt; cA = nA; cB = nB; ++ui;
        if constexpr (ALIGN_EPI) { if (wr == 1) PG8_BAR; }
    }
    PG8_WAIT_V(0);
    if constexpr (!ALIGN_EPI) { if (wr == 0) PG8_BAR; }
    PG8_BAR;
#undef PG8_SA
#undef PG8_SB
#undef PG8_STAGE
#undef PG8_LDA
#undef PG8_LDB
#undef PG8_MMA
#undef PG8_MMA1
#undef PG8_WAIT_V
#undef PG8_WAIT_L
#undef PG8_BAR
#undef PG8_SCHED
}
}

#define GAS __attribute__((address_space(1)))
#define LAS __attribute__((address_space(3)))
typedef unsigned short bf16;
typedef pg8::f32x4 f32x4;
typedef pg8::f32x2 f32x2;
typedef pg8::u32x4 u32x4;
typedef pg8::u32x2 u32x2;
typedef pg8::bf16x8 bf16x8;
constexpr int NWAVES = 8, NTHR = 512;
constexpr int M = 32768, DM = 1024, SEQ = 4096;
constexpr float EPS = 1e-6f;
constexpr size_t MiB = 1u << 20;
constexpr size_t WS_CTL = 0, CTL_ZERO_BYTES = 1 * MiB;
constexpr size_t WS_ROPE = 1 * MiB;
constexpr size_t WS_WIN = 2 * MiB, WS_WGLU = 12 * MiB, WS_WOUT = 14 * MiB, WS_WINC = 18 * MiB, WS_WOUTC = 24 * MiB;
constexpr size_t WS_TG = 26 * MiB, WS_WG = 38 * MiB, WS_L16 = 46 * MiB, WS_KVSEG = 48 * MiB;
constexpr size_t WS_XN = 64 * MiB;
constexpr size_t WS_AEXT = 128 * MiB;
constexpr size_t WS_SG5 = 224 * MiB, WS_Q = 288 * MiB, WS_K = 320 * MiB, WS_V = 352 * MiB, WS_SGR = 416 * MiB;
constexpr size_t WS_X1 = 128 * MiB, WS_U2 = 256 * MiB, WS_SG2 = 320 * MiB, WS_V2 = 384 * MiB, WS_END = 480 * MiB;
constexpr int LDS_BYTES = 147456;
constexpr int AEXT_LD = 384;

__device__ __forceinline__ float fsigmoid(float x) { return __builtin_amdgcn_rcpf(1.0f + __expf(-x)); }
__device__ __forceinline__ float fsilu(float x) { return x * fsigmoid(x); }
__device__ __forceinline__ float fgelu_tanh(float x) { const float u = 1.5957691216f * (x + 0.044715f * x * x * x); return x * fsigmoid(u); }
__device__ __forceinline__ unsigned f2bf(float f) { unsigned u = __builtin_bit_cast(unsigned, f); return (u + 0x7fffu + ((u >> 16) & 1u)) >> 16; }
__device__ __forceinline__ float bf2f(unsigned h) { return __builtin_bit_cast(float, h << 16); }
__device__ __forceinline__ unsigned pk2(float lo, float hi) { return pg8::cvt_pk_bf16(lo, hi); }
__device__ __forceinline__ u32x4 pack8(f32x4 a, f32x4 b) { u32x4 w; w.x = pk2(a[0], a[1]); w.y = pk2(a[2], a[3]); w.z = pk2(b[0], b[1]); w.w = pk2(b[2], b[3]); return w; }
__device__ __forceinline__ void unpack8(u32x4 w, f32x4& a, f32x4& b) {
    a[0] = bf2f(w.x & 0xffffu); a[1] = bf2f(w.x >> 16); a[2] = bf2f(w.y & 0xffffu); a[3] = bf2f(w.y >> 16);
    b[0] = bf2f(w.z & 0xffffu); b[1] = bf2f(w.z >> 16); b[2] = bf2f(w.w & 0xffffu); b[3] = bf2f(w.w >> 16); }
__device__ __forceinline__ float wave_sum(float v) {
#pragma unroll
    for (int o = 1; o < 64; o <<= 1) v += __shfl_xor(v, o);
    return v;
}

typedef f32x4 AccT[2][2][4][2];

struct EpiWin {
    static constexpr bool PERM = true;
    bf16 *Aext, *SG5, *Q, *Kb, *V, *SGR; const float *ropec, *ropes;
    __device__ __forceinline__ void operator()(const AccT& acc, const pg8::Unit& u, int wr, int wc, int fr, int fq) const {
        const int pn = u.pn, row0 = u.pm * 256 + wr * 64 + fr;
#pragma unroll
        for (int ai = 0; ai < 2; ++ai)
#pragma unroll
            for (int m = 0; m < 4; ++m) { const int row = row0 + ai * 128 + m * 16;
#pragma unroll
                for (int bj = 0; bj < 2; ++bj) { const int colt = pn * 256 + bj * 128 + wc * 32 + 8 * fq;
                    f32x4 v0 = acc[ai][bj][m][0], v1 = acc[ai][bj][m][1];
                    if (pn < 4) {
                        const int g = colt >> 4, h0 = colt & 15;
                        bf16* dst = Aext + (size_t)g * (2048 * AEXT_LD) + (size_t)(row >> 4) * AEXT_LD + (row & 15) * 16 + h0;
                        *(u32x4*)dst = pack8(v0, v1);
                    } else if (pn < 8) {
#pragma unroll
                        for (int i = 0; i < 4; ++i) { v0[i] = fsilu(v0[i]); v1[i] = fsilu(v1[i]); }
                        *(u32x4*)(SG5 + (size_t)row * 1024 + (colt - 1024)) = pack8(v0, v1);
                    } else if (pn < 12) {
                        const bool isq = pn < 10; const int c = colt - (isq ? 2048 : 2560); const int j = (c & 63) >> 3; const int pos = row & (SEQ - 1);
                        const f32x4 cs = *(const f32x4*)(ropec + pos * 32 + 4 * j), sn = *(const f32x4*)(ropes + pos * 32 + 4 * j);
                        const float sc = isq ? 0.125f : 1.0f;
                        f32x4 o1 = (v0 * cs - v1 * sn) * sc, o2 = (v0 * sn + v1 * cs) * sc;
                        *(u32x4*)((isq ? Q : Kb) + (size_t)row * 512 + c) = pack8(o1, o2);
                    } else if (pn < 16) {
                        *(u32x4*)(V + (size_t)row * 1024 + (colt - 3072)) = pack8(v0, v1);
                    } else {
#pragma unroll
                        for (int i = 0; i < 4; ++i) { v0[i] = fsilu(v0[i]); v1[i] = fsilu(v1[i]); }
                        *(u32x4*)(SGR + (size_t)row * 1024 + (colt - 4096)) = pack8(v0, v1);
                    } } }
    }
};
struct EpiSloc {
    static constexpr bool PERM = false;
    float* O;
    __device__ __forceinline__ void operator()(const AccT& acc, const pg8::Unit& u, int wr, int wc, int fr, int fq) const {
        const int row0 = u.pm * 256 + wr * 64 + fr, col0 = wc * 32 + 4 * fq;
#pragma unroll
        for (int ai = 0; ai < 2; ++ai)
#pragma unroll
            for (int m = 0; m < 4; ++m) { float* rowp = O + (size_t)(row0 + ai * 128 + m * 16) * 128 + col0;
#pragma unroll
                for (int n = 0; n < 2; ++n) *(f32x4*)(rowp + 16 * n) = acc[ai][0][m][n]; }
    }
};
struct EpiYg {
    static constexpr bool PERM = true;
    bf16* O;
    __device__ __forceinline__ void operator()(const AccT& acc, const pg8::Unit& u, int wr, int wc, int fr, int fq) const {
        const int row0 = u.pm * 256 + wr * 64 + fr, col0 = wc * 32 + 8 * fq;
#pragma unroll
        for (int ai = 0; ai < 2; ++ai)
#pragma unroll
            for (int m = 0; m < 4; ++m) { bf16* rowp = O + (size_t)(row0 + ai * 128 + m * 16) * 256 + col0;
#pragma unroll
                for (int bj = 0; bj < 2; ++bj) { f32x4 v0 = acc[ai][bj][m][0], v1 = acc[ai][bj][m][1];
#pragma unroll
                    for (int i = 0; i < 4; ++i) { v0[i] = fgelu_tanh(v0[i]); v1[i] = fgelu_tanh(v1[i]); }
                    *(u32x4*)(rowp + bj * 128) = pack8(v0, v1); } }
    }
};
struct EpiGlu {
    static constexpr bool PERM = true;
    const bf16* Yg; const bf16* SG5; const float* bias; bf16* Ymix;
    __device__ __forceinline__ void operator()(const AccT& acc, const pg8::Unit& u, int wr, int wc, int fr, int fq) const {
        const int row0 = u.pm * 256 + wr * 64 + fr, colb = u.pn * 256 + wc * 32 + 8 * fq;
        f32x4 bv[2][2];
#pragma unroll
        for (int bj = 0; bj < 2; ++bj)
#pragma unroll
            for (int n = 0; n < 2; ++n) bv[bj][n] = *(const f32x4*)(bias + colb + bj * 128 + 4 * n);
#pragma unroll
        for (int ai = 0; ai < 2; ++ai)
#pragma unroll
            for (int m = 0; m < 4; ++m) { const int row = row0 + ai * 128 + m * 16;
#pragma unroll
                for (int bj = 0; bj < 2; ++bj) { const int c = colb + bj * 128;
                    const u32x4 yw = *(const u32x4*)(Yg + ((size_t)(c >> 4) * M + row) * 16 + (c & 15));
                    const u32x4 gw = *(const u32x4*)(SG5 + (size_t)row * 1024 + c);
                    f32x4 y0, y1, g0, g1; unpack8(yw, y0, y1); unpack8(gw, g0, g1);
                    f32x4 z0 = acc[ai][bj][m][0] + bv[bj][0], z1 = acc[ai][bj][m][1] + bv[bj][1];
#pragma unroll
                    for (int i = 0; i < 4; ++i) { z0[i] = y0[i] * fsigmoid(z0[i]) * g0[i]; z1[i] = y1[i] * fsigmoid(z1[i]) * g1[i]; }
                    *(u32x4*)(Ymix + (size_t)row * 2048 + c) = pack8(z0, z1); }
                asm volatile("" ::: "memory"); }
    }
};
struct EpiWout {
    static constexpr bool PERM = false;
    const float* X; float* X1; bf16* XG2; const float* g1; float* ss1;
    __device__ __forceinline__ void operator()(const AccT& acc, const pg8::Unit& u, int wr, int wc, int fr, int fq) const {
        const int row0 = u.pm * 256 + wr * 64 + fr, colb = u.pn * 256 + wc * 32 + 4 * fq;
        f32x4 gv[2][2];
#pragma unroll
        for (int bj = 0; bj < 2; ++bj)
#pragma unroll
            for (int n = 0; n < 2; ++n) gv[bj][n] = *(const f32x4*)(g1 + colb + bj * 128 + 16 * n);
#pragma unroll
        for (int ai = 0; ai < 2; ++ai)
#pragma unroll
            for (int m = 0; m < 4; ++m) { const int row = row0 + ai * 128 + m * 16; const size_t off = (size_t)row * 1024 + colb; float s = 0.f;
#pragma unroll
                for (int bj = 0; bj < 2; ++bj)
#pragma unroll
                    for (int n = 0; n < 2; ++n) { const f32x4 xv = *(const f32x4*)(X + off + bj * 128 + 16 * n); const f32x4 x1 = xv + acc[ai][bj][m][n];
                        *(f32x4*)(X1 + off + bj * 128 + 16 * n) = x1; s += (x1[0] * x1[0] + x1[1] * x1[1]) + (x1[2] * x1[2] + x1[3] * x1[3]);
                        const f32x4 xg = x1 * gv[bj][n]; u32x2 w; w.x = pk2(xg[0], xg[1]); w.y = pk2(xg[2], xg[3]); *(u32x2*)(XG2 + off + bj * 128 + 16 * n) = w; }
                s += __shfl_xor(s, 16); s += __shfl_xor(s, 32);
                if (fq == 0) atomicAdd(ss1 + row, s);
                asm volatile("" ::: "memory"); }
    }
};
struct EpiWinC {
    static constexpr bool PERM = true;
    const float* ss1; bf16* U2; bf16* SG2;
    __device__ __forceinline__ void operator()(const AccT& acc, const pg8::Unit& u, int wr, int wc, int fr, int fq) const {
        const int pn = u.pn, row0 = u.pm * 256 + wr * 64 + fr;
#pragma unroll
        for (int ai = 0; ai < 2; ++ai)
#pragma unroll
            for (int m = 0; m < 4; ++m) { const int row = row0 + ai * 128 + m * 16; const float r = rsqrtf(ss1[row] * (1.0f / 1024.0f) + EPS);
                if (pn < 8) {
                    f32x4 a0 = acc[ai][0][m][0] * r, a1 = acc[ai][0][m][1] * r, b0 = acc[ai][1][m][0] * r, b1 = acc[ai][1][m][1] * r;
#pragma unroll
                    for (int i = 0; i < 4; ++i) { a0[i] *= fsigmoid(b0[i]); a1[i] *= fsigmoid(b1[i]); }
                    *(u32x4*)(U2 + (size_t)row * 1024 + pn * 128 + wc * 32 + 8 * fq) = pack8(a0, a1);
                } else {
#pragma unroll
                    for (int bj = 0; bj < 2; ++bj) { f32x4 v0 = acc[ai][bj][m][0] * r, v1 = acc[ai][bj][m][1] * r;
#pragma unroll
                        for (int i = 0; i < 4; ++i) { v0[i] = fsilu(v0[i]); v1[i] = fsilu(v1[i]); }
                        *(u32x4*)(SG2 + (size_t)row * 1024 + (pn - 8) * 256 + bj * 128 + wc * 32 + 8 * fq) = pack8(v0, v1); }
                } }
    }
};
struct EpiWoutC {
    static constexpr bool PERM = false;
    const float* X1; float* O;
    __device__ __forceinline__ void operator()(const AccT& acc, const pg8::Unit& u, int wr, int wc, int fr, int fq) const {
        const int row0 = u.pm * 256 + wr * 64 + fr, colb = u.pn * 256 + wc * 32 + 4 * fq;
#pragma unroll
        for (int ai = 0; ai < 2; ++ai)
#pragma unroll
            for (int m = 0; m < 4; ++m) { const size_t off = (size_t)(row0 + ai * 128 + m * 16) * 1024 + colb;
#pragma unroll
                for (int bj = 0; bj < 2; ++bj)
#pragma unroll
                    for (int n = 0; n < 2; ++n) { const f32x4 xv = *(const f32x4*)(X1 + off + bj * 128 + 16 * n); *(f32x4*)(O + off + bj * 128 + 16 * n) = xv + acc[ai][bj][m][n]; }
                asm volatile("" ::: "memory"); }
    }
};

#define LDS_WAIT() asm volatile("s_waitcnt lgkmcnt(0)" ::: "memory")
__device__ __forceinline__ int dest_row(int n, int mode) {
    if (mode == 1) { if (n >= 2048 && n < 3072) { const int d = n & 63; return (n & ~63) + 8 * ((d & 31) >> 2) + 4 * (d >> 5) + (d & 3); } return n; }
    if (mode == 2) { if (n < 1024) return 256 * (n >> 7) + (n & 127); if (n < 2048) { const int q = n - 1024; return 256 * (q >> 7) + 128 + (q & 127); } return n; }
    return n;
}
__device__ __forceinline__ void p0_transpose_item(const float* W, int K, int N, bf16* WT, int mode, LAS float* scr, int item, int lane) {
    const int nblk = N / 32, kb = item / nblk, nb = item % nblk, k0 = 64 * kb, n0 = 32 * nb;
#pragma unroll 8
    for (int i = 0; i < 32; ++i) { const int kk = 2 * i + (lane >> 5); scr[kk * 33 + (lane & 31)] = W[(size_t)(k0 + kk) * N + n0 + (lane & 31)]; }
    LDS_WAIT(); asm volatile("" ::: "memory");
    const int c = lane & 7;
#pragma unroll
    for (int j = 0; j < 4; ++j) { const int n = (lane >> 3) + 8 * j; const LAS float* s = scr + (8 * c) * 33 + n;
        u32x4 o; o.x = pk2(s[0 * 33], s[1 * 33]); o.y = pk2(s[2 * 33], s[3 * 33]); o.z = pk2(s[4 * 33], s[5 * 33]); o.w = pk2(s[6 * 33], s[7 * 33]);
        *(u32x4*)(WT + (size_t)dest_row(n0 + n, mode) * K + k0 + 8 * c) = o; }
    LDS_WAIT(); asm volatile("" ::: "memory");
}
__device__ __forceinline__ void rms_row_to_bf16(const float* xrow, const float* g, bf16* orow, int lane) {
    const f32x4* xr = (const f32x4*)xrow + lane; const f32x4* gr = (const f32x4*)g + lane;
    f32x4 v[4]; float s = 0.f;
#pragma unroll
    for (int j = 0; j < 4; ++j) { v[j] = xr[64 * j]; s += (v[j][0] * v[j][0] + v[j][1] * v[j][1]) + (v[j][2] * v[j][2] + v[j][3] * v[j][3]); }
    const float r = rsqrtf(wave_sum(s) * (1.f / 1024.f) + EPS);
    u32x2* o8 = (u32x2*)orow + lane;
#pragma unroll
    for (int j = 0; j < 4; ++j) { const f32x4 gg = gr[64 * j]; u32x2 w; w.x = pk2(v[j][0] * r * gg[0], v[j][1] * r * gg[1]); w.y = pk2(v[j][2] * r * gg[2], v[j][3] * r * gg[3]); o8[64 * j] = w; }
}
__device__ __forceinline__ void rms_row_f32(float* xrow, const float* g, int lane) {
    f32x4* xr = (f32x4*)xrow + lane; const f32x4* gr = (const f32x4*)g + lane;
    f32x4 v[4]; float s = 0.f;
#pragma unroll
    for (int j = 0; j < 4; ++j) { v[j] = xr[64 * j]; s += (v[j][0] * v[j][0] + v[j][1] * v[j][1]) + (v[j][2] * v[j][2] + v[j][3] * v[j][3]); }
    const float r = rsqrtf(wave_sum(s) * (1.f / 1024.f) + EPS);
#pragma unroll
    for (int j = 0; j < 4; ++j) xr[64 * j] = v[j] * r * gr[64 * j];
}

__device__ __forceinline__ void cpow_table(float rho, float theta, int k, float& pr, float& pi) {
    const float mag = __expf(rho * (float)k);
    const double ang = (double)theta * (double)k; const double tw = 6.283185307179586476925286766559;
    const float red = (float)(ang - tw * __builtin_rint(ang / tw));
    pr = mag * cosf(red); pi = mag * sinf(red);
}
__device__ __forceinline__ void s5_tables_item(int item, LAS float* L, const float* a_re, const float* a_im, const float* log_dt, const float* b_re, const float* b_im,
                                               const float* c_re, const float* c_im, const float* dskip, bf16* Tg, bf16* Wg, float* L16, int tid) {
    const int g = item >> 4, k = item & 15;
    LAS float* Lkr = L; LAS float* Lki = L + 64; LAS float* L1r = L + 128; LAS float* L1i = L + 192; LAS float* cfr = L + 256; LAS float* cfi = L + 320;
    LAS float* Bbr = L + 384; LAS float* Bbi = Bbr + 1024; LAS float* Cr = Bbi + 1024; LAS float* Ci = Cr + 1024; LAS float* Kk = Ci + 1024;
    if (tid < 64) { const int n = tid; const float are = a_re[g * 64 + n], aim = a_im[g * 64 + n], dt = expf(log_dt[g]);
        const float rho = are * dt, theta = aim * dt;
        float lr, li; cpow_table(rho, theta, 1, lr, li);
        const float mag = expf(rho); const float sh = sinf(0.5f * theta);
        const float nr = expm1f(rho) * cosf(theta) - 2.0f * sh * sh, ni = li; (void)mag; (void)lr;
        const float den = are * are + aim * aim;
        cfr[n] = (nr * are + ni * aim) / den; cfi[n] = (ni * are - nr * aim) / den;
        float pr, pi; cpow_table(rho, theta, k, pr, pi); Lkr[n] = pr; Lki[n] = pi;
        cpow_table(rho, theta, k + 1, pr, pi); L1r[n] = pr; L1i[n] = pi;
        if (k == 15) { L16[g * 128 + n] = pr; L16[g * 128 + 64 + n] = pi; }
    }
    for (int e = tid; e < 1024; e += NTHR) { Cr[e] = c_re[g * 1024 + e]; Ci[e] = c_im[g * 1024 + e]; }
    __syncthreads();
    for (int e = tid; e < 1024; e += NTHR) { const int n = e >> 4; const float br = b_re[g * 1024 + e], bi = b_im[g * 1024 + e];
        Bbr[e] = cfr[n] * br - cfi[n] * bi; Bbi[e] = cfr[n] * bi + cfi[n] * br; }
    __syncthreads();
    if (tid < 256) { const int ho = tid >> 4, hi = tid & 15; float s = 0.f;
        for (int n = 0; n < 64; ++n) { const float clr = Cr[ho * 64 + n] * Lkr[n] - Ci[ho * 64 + n] * Lki[n], cli = Cr[ho * 64 + n] * Lki[n] + Ci[ho * 64 + n] * Lkr[n];
            s += clr * Bbr[n * 16 + hi] - cli * Bbi[n * 16 + hi]; }
        if (k == 0 && ho == hi) s += dskip[g * 16 + ho];
        Kk[tid] = s; }
    __syncthreads();
    bf16* Tgg = Tg + (size_t)g * 256 * AEXT_LD;
    {
        const int bi = tid >> 5, ho = (tid & 31) >> 1, h8 = (tid & 1) * 8;
        if (bi >= k) { const int to = bi, ti = bi - k; const LAS float* s = Kk + ho * 16 + h8;
            u32x4 w; w.x = pk2(s[0], s[1]); w.y = pk2(s[2], s[3]); w.z = pk2(s[4], s[5]); w.w = pk2(s[6], s[7]);
            *(u32x4*)(Tgg + (size_t)(to * 16 + ho) * AEXT_LD + ti * 16 + h8) = w; }
        if (k >= 1 && bi + k <= 15) { const int to = bi, ti = bi + k; *(u32x4*)(Tgg + (size_t)(to * 16 + ho) * AEXT_LD + ti * 16 + h8) = (u32x4){0u, 0u, 0u, 0u}; }
    }
    for (int e = tid; e < 1024; e += NTHR) { const int ho = e >> 6, n = e & 63;
        const float vr = Cr[e] * L1r[n] - Ci[e] * L1i[n], vi = Cr[e] * L1i[n] + Ci[e] * L1r[n];
        bf16* rowp = Tgg + (size_t)(k * 16 + ho) * AEXT_LD + 256;
        rowp[n] = (bf16)f2bf(vr); rowp[64 + n] = (bf16)f2bf(-vi); }
    {
        const int np = tid >> 1, h8 = (tid & 1) * 8, ti = 15 - k; float v[8];
#pragma unroll
        for (int x = 0; x < 8; ++x) { float val = 0.f;
            if (np < 128) { const int n = np & 63; const float br = Bbr[n * 16 + h8 + x], bi2 = Bbi[n * 16 + h8 + x];
                val = np < 64 ? (Lkr[n] * br - Lki[n] * bi2) : (Lkr[n] * bi2 + Lki[n] * br); }
            v[x] = val; }
        u32x4 w; w.x = pk2(v[0], v[1]); w.y = pk2(v[2], v[3]); w.z = pk2(v[4], v[5]); w.w = pk2(v[6], v[7]);
        *(u32x4*)(Wg + ((size_t)g * 256 + np) * 256 + ti * 16 + h8) = w;
    }
    __syncthreads();
}

__device__ __forceinline__ void s5_scan_item(int item, LAS float* L, const float* Sloc, const float* L16, bf16* Aext, int tid) {
    const int g = item >> 3, b = item & 7, seg = tid >> 6, n = tid & 63;
    const float ar = L16[g * 128 + n], ai = L16[g * 128 + 64 + n];
    const float* sl = Sloc + (size_t)(g * 2048 + b * 256 + seg * 32) * 128 + n;
    float er = 0.f, ei = 0.f;
#pragma unroll 8
    for (int c = 0; c < 32; ++c) { const float sr = sl[c * 128], si = sl[c * 128 + 64]; const float t = ar * er - ai * ei + sr; ei = ar * ei + ai * er + si; er = t; }
    float pr = ar, pi = ai;
#pragma unroll
    for (int i = 0; i < 5; ++i) { const float t = pr * pr - pi * pi; pi = 2.f * pr * pi; pr = t; }
    L[(seg * 64 + n) * 2] = er; L[(seg * 64 + n) * 2 + 1] = ei;
    __syncthreads();
    float xr = 0.f, xi = 0.f;
    for (int s = 0; s < seg; ++s) { const float qr = L[(s * 64 + n) * 2], qi = L[(s * 64 + n) * 2 + 1]; const float t = pr * xr - pi * xi + qr; xi = pr * xi + pi * xr + qi; xr = t; }
    bf16* dst = Aext + (size_t)(g * 2048 + b * 256 + seg * 32) * AEXT_LD + 256 + n;
#pragma unroll 8
    for (int c = 0; c < 32; ++c) { const float sr = sl[c * 128], si = sl[c * 128 + 64];
        dst[c * AEXT_LD] = (bf16)f2bf(xr); dst[c * AEXT_LD + 64] = (bf16)f2bf(xi);
        const float t = ar * xr - ai * xi + sr; xi = ar * xi + ai * xr + si; xr = t; }
    __syncthreads();
}

constexpr int RP = 72;
template <bool FULL>
__device__ __forceinline__ void retention_item(int item, LAS unsigned char* lds, const bf16* Q, const bf16* Kb, const bf16* V, const bf16* SGR, float* KVseg, bf16* Ymix, int tid) {
    const int b = item >> 5, h = (item >> 2) & 7, seg = item & 3;
    const int wid = tid >> 6, lane = tid & 63, l15 = lane & 15, q4 = lane >> 4;
    LAS bf16* Qs = (LAS bf16*)lds; LAS bf16* Ks = Qs + 64 * RP; LAS bf16* KTs = Ks + 64 * RP; LAS bf16* VTs = KTs + 64 * RP;
    LAS bf16* Ps = VTs + 128 * RP; LAS bf16* STs = Ps + 64 * RP; LAS float* stat = (LAS float*)(STs + 128 * RP);
    const float lg2 = log2f(1.0f - exp2f(-5.0f - (float)h));
    const float d64 = exp2f(lg2 * 64.0f);
    const int db = wid >> 1, et0 = (wid & 1) * 4;
    f32x4 Sacc[4];
#pragma unroll
    for (int t = 0; t < 4; ++t) Sacc[t] = (f32x4){0.f, 0.f, 0.f, 0.f};
    if (FULL) {
        const float w1024 = exp2f(lg2 * 1024.0f); float wgt = 1.0f;
        for (int s = seg - 1; s >= 0; --s) { const float* kv = KVseg + (size_t)((b * 8 + h) * 4 + s) * 8192;
#pragma unroll
            for (int t = 0; t < 4; ++t)
#pragma unroll
                for (int r = 0; r < 4; ++r) Sacc[t][r] += wgt * kv[(db * 16 + 4 * q4 + r) * 128 + (et0 + t) * 16 + l15];
            wgt *= w1024; }
#pragma unroll
        for (int t = 0; t < 4; ++t) { u32x2 w; w.x = pk2(Sacc[t][0], Sacc[t][1]); w.y = pk2(Sacc[t][2], Sacc[t][3]); *(LAS u32x2*)(STs + ((et0 + t) * 16 + l15) * RP + db * 16 + 4 * q4) = w; }
    }
    const int tok_seg = b * SEQ + seg * 1024;
    for (int ch = 0; ch < 16; ++ch) {
        const int tok0 = tok_seg + ch * 64;
        {
            const int row = tid >> 3, cp = tid & 7;
            const u32x4 kw = *(const u32x4*)(Kb + (size_t)(tok0 + row) * 512 + h * 64 + cp * 8);
            u32x4 qw; if (FULL) qw = *(const u32x4*)(Q + (size_t)(tok0 + row) * 512 + h * 64 + cp * 8);
            u32x4 vw[2];
#pragma unroll
            for (int i = 0; i < 2; ++i) { const int p = tid + 512 * i; vw[i] = *(const u32x4*)(V + (size_t)(tok0 + (p >> 4)) * 1024 + h * 128 + (p & 15) * 8); }
            if (FULL) { *(LAS u32x4*)(Ks + row * RP + cp * 8) = kw; *(LAS u32x4*)(Qs + row * RP + cp * 8) = qw; }
            const float kd = exp2f(lg2 * (float)(63 - row));
            f32x4 k0, k1; unpack8(kw, k0, k1);
#pragma unroll
            for (int x = 0; x < 4; ++x) { KTs[(cp * 8 + x) * RP + row] = (bf16)f2bf(k0[x] * kd); KTs[(cp * 8 + 4 + x) * RP + row] = (bf16)f2bf(k1[x] * kd); }
#pragma unroll
            for (int i = 0; i < 2; ++i) { const int p = tid + 512 * i, vr = p >> 4, vc = (p & 15) * 8; const unsigned ww[4] = {vw[i].x, vw[i].y, vw[i].z, vw[i].w};
#pragma unroll
                for (int x = 0; x < 4; ++x) { VTs[(vc + 2 * x) * RP + vr] = (bf16)(ww[x] & 0xffffu); VTs[(vc + 2 * x + 1) * RP + vr] = (bf16)(ww[x] >> 16); } }
        }
        __syncthreads();
        f32x4 oacc[4], cacc[4];
        if (FULL) {
            const int ib = wid >> 1;
#pragma unroll
            for (int jj = 0; jj < 2; ++jj) { const int jb = (wid & 1) * 2 + jj; f32x4 sacc = (f32x4){0.f, 0.f, 0.f, 0.f};
#pragma unroll
                for (int ks = 0; ks < 2; ++ks) { const bf16x8 af = *(const LAS bf16x8*)(Ks + (jb * 16 + l15) * RP + ks * 32 + 8 * q4); const bf16x8 bfr = *(const LAS bf16x8*)(Qs + (ib * 16 + l15) * RP + ks * 32 + 8 * q4);
                    sacc = __builtin_amdgcn_mfma_f32_16x16x32_bf16(af, bfr, sacc, 0, 0, 0); }
                const int i = ib * 16 + l15, j0 = jb * 16 + 4 * q4; float pv[4];
#pragma unroll
                for (int r = 0; r < 4; ++r) { const int dist = i - (j0 + r); pv[r] = sacc[r] * exp2f(lg2 * (float)(dist < 0 ? -dist : dist)); }
                u32x2 w; w.x = pk2(pv[0], pv[1]); w.y = pk2(pv[2], pv[3]); *(LAS u32x2*)(Ps + i * RP + j0) = w; }
            __syncthreads();
#pragma unroll
            for (int t = 0; t < 4; ++t) { oacc[t] = (f32x4){0.f, 0.f, 0.f, 0.f}; cacc[t] = (f32x4){0.f, 0.f, 0.f, 0.f}; }
#pragma unroll
            for (int ks = 0; ks < 2; ++ks) { const bf16x8 pa = *(const LAS bf16x8*)(Ps + (ib * 16 + l15) * RP + ks * 32 + 8 * q4); const bf16x8 qa = *(const LAS bf16x8*)(Qs + (ib * 16 + l15) * RP + ks * 32 + 8 * q4);
#pragma unroll
                for (int t = 0; t < 4; ++t) { const bf16x8 vb = *(const LAS bf16x8*)(VTs + ((et0 + t) * 16 + l15) * RP + ks * 32 + 8 * q4); const bf16x8 sb = *(const LAS bf16x8*)(STs + ((et0 + t) * 16 + l15) * RP + ks * 32 + 8 * q4);
                    oacc[t] = __builtin_amdgcn_mfma_f32_16x16x32_bf16(pa, vb, oacc[t], 0, 0, 0); cacc[t] = __builtin_amdgcn_mfma_f32_16x16x32_bf16(qa, sb, cacc[t], 0, 0, 0); } }
#pragma unroll
            for (int r = 0; r < 4; ++r) { const int i = ib * 16 + 4 * q4 + r; const float qd = exp2f(lg2 * (float)(i + 1)); float s = 0.f, sq = 0.f;
#pragma unroll
                for (int t = 0; t < 4; ++t) { const float o = oacc[t][r] + qd * cacc[t][r]; oacc[t][r] = o; s += o; sq += o * o; }
#pragma unroll
                for (int o = 1; o < 16; o <<= 1) { s += __shfl_xor(s, o); sq += __shfl_xor(sq, o); }
                if (l15 == 0) { stat[i * 4 + (wid & 1) * 2] = s; stat[i * 4 + (wid & 1) * 2 + 1] = sq; } }
            __syncthreads();
#pragma unroll
            for (int r = 0; r < 4; ++r) { const int i = ib * 16 + 4 * q4 + r; const f32x4 st = *(const LAS f32x4*)(stat + i * 4);
                const float mean = (st[0] + st[2]) * (1.f / 128.f); const float var = (st[1] + st[3]) * (1.f / 128.f) - mean * mean; const float rstd = rsqrtf(fmaxf(var, 0.f) + EPS);
                const size_t tok = (size_t)(tok0 + i);
#pragma unroll
                for (int t = 0; t < 4; ++t) { const int e = (et0 + t) * 16 + l15; const float gte = bf2f(SGR[tok * 1024 + h * 128 + e]);
                    Ymix[tok * 2048 + 1024 + h * 128 + e] = (bf16)f2bf((oacc[t][r] - mean) * rstd * gte); } }
        }
#pragma unroll
        for (int t = 0; t < 4; ++t) Sacc[t] = Sacc[t] * d64;
#pragma unroll
        for (int ks = 0; ks < 2; ++ks) { const bf16x8 ka = *(const LAS bf16x8*)(KTs + (db * 16 + l15) * RP + ks * 32 + 8 * q4);
#pragma unroll
            for (int t = 0; t < 4; ++t) { const bf16x8 vb = *(const LAS bf16x8*)(VTs + ((et0 + t) * 16 + l15) * RP + ks * 32 + 8 * q4); Sacc[t] = __builtin_amdgcn_mfma_f32_16x16x32_bf16(ka, vb, Sacc[t], 0, 0, 0); } }
        if (FULL) {
#pragma unroll
            for (int t = 0; t < 4; ++t) { u32x2 w; w.x = pk2(Sacc[t][0], Sacc[t][1]); w.y = pk2(Sacc[t][2], Sacc[t][3]); *(LAS u32x2*)(STs + ((et0 + t) * 16 + l15) * RP + db * 16 + 4 * q4) = w; }
        }
        __syncthreads();
    }
    if (!FULL) { float* kv = KVseg + (size_t)item * 8192;
#pragma unroll
        for (int t = 0; t < 4; ++t)
#pragma unroll
            for (int r = 0; r < 4; ++r) kv[(db * 16 + 4 * q4 + r) * 128 + (et0 + t) * 16 + l15] = Sacc[t][r]; }
}

__device__ __forceinline__ void conv_item(int item, LAS unsigned char* lds, const bf16* U2, const bf16* SG2, const float* cw, const float* cb, const float* lng, const float* lnb, bf16* V2, int tid) {
    const int b = item >> 7, l0 = (item & 127) * 32, c0 = 2 * tid;
    LAS float* T = (LAS float*)lds;
    {
        f32x2 w[31];
        const char* cwb = (const char*)cw; const unsigned coff = (unsigned)c0 * 4u;
#pragma unroll
        for (int k = 0; k < 31; ++k) w[k] = *(const f32x2*)(cwb + (coff + (unsigned)k * 4096u));
        const f32x2 bias = *(const f32x2*)(cb + c0);
        const char* ub = (const char*)U2;
#pragma unroll 1
        for (int hf = 0; hf < 2; ++hf) {
            f32x2 u[46]; const int lb = l0 - 30 + hf * 16;
#pragma unroll
            for (int j = 0; j < 46; ++j) { const int l = lb + j; unsigned uw = 0u;
                if (l >= 0) uw = *(const unsigned*)(ub + ((unsigned)(b * SEQ + l) * 2048u + (unsigned)c0 * 2u));
                u[j][0] = bf2f(uw & 0xffffu); u[j][1] = bf2f(uw >> 16); }
#pragma unroll
            for (int t = 0; t < 16; ++t) { f32x2 a = bias;
#pragma unroll
                for (int k = 0; k < 31; ++k) a += w[k] * u[t + k];
                *(LAS f32x2*)(T + (hf * 16 + t) * 1024 + c0) = a; }
        }
    }
    __syncthreads();
    const int wid = tid >> 6, lane = tid & 63;
#pragma unroll
    for (int tt = 0; tt < 4; ++tt) { const int t = wid * 4 + tt; const size_t tok = (size_t)(b * SEQ + l0 + t);
        f32x4 v[4]; float s = 0.f;
#pragma unroll
        for (int q = 0; q < 4; ++q) { v[q] = *(const LAS f32x4*)(T + t * 1024 + lane * 4 + 256 * q); s += (v[q][0] + v[q][1]) + (v[q][2] + v[q][3]); }
        const float mean = wave_sum(s) * (1.f / 1024.f); float s2 = 0.f;
#pragma unroll
        for (int q = 0; q < 4; ++q) { v[q] = v[q] - mean; s2 += (v[q][0] * v[q][0] + v[q][1] * v[q][1]) + (v[q][2] * v[q][2] + v[q][3] * v[q][3]); }
        const float rstd = rsqrtf(wave_sum(s2) * (1.f / 1024.f) + EPS);
#pragma unroll
        for (int q = 0; q < 4; ++q) { const int c = lane * 4 + 256 * q; const f32x4 gg = *(const f32x4*)(lng + c), bb = *(const f32x4*)(lnb + c);
            const u32x2 gw = *(const u32x2*)(SG2 + tok * 1024 + c); float o[4];
            const float gt[4] = {bf2f(gw.x & 0xffffu), bf2f(gw.x >> 16), bf2f(gw.y & 0xffffu), bf2f(gw.y >> 16)};
#pragma unroll
            for (int i = 0; i < 4; ++i) o[i] = fsilu(v[q][i] * rstd * gg[i] + bb[i]) * gt[i];
            u32x2 w; w.x = pk2(o[0], o[1]); w.y = pk2(o[2], o[3]); *(u32x2*)(V2 + tok * 1024 + c) = w; } }
    __syncthreads();
}

#ifndef MK_PER_PHASE
#define MK_PER_PHASE 0
#endif
constexpr int N_PHASES = 11;
struct Args { const float* in[21]; float* out; unsigned char* ws; int ph_lo, ph_hi; };

__global__ void __launch_bounds__(NTHR, 2) fwd_megakernel(Args args) {
    extern __shared__ __attribute__((aligned(16))) unsigned char lds_raw[];
    LAS unsigned char* lds = (LAS unsigned char*)lds_raw;
    const int tid = threadIdx.x, lane = tid & 63, wave = __builtin_amdgcn_readfirstlane(tid >> 6);
    const int G = gridDim.x, bid = blockIdx.x;
    const int gw = bid * NWAVES + wave, NGW = G * NWAVES;
    unsigned char* ws = args.ws;
    const float* x = args.in[0]; const float* norm_g = args.in[1]; const float* final_g = args.in[2]; const float* w_in_ab = args.in[3];
    const float* s5_a_re = args.in[4]; const float* s5_a_im = args.in[5]; const float* s5_log_dt = args.in[6]; const float* s5_b_re = args.in[7]; const float* s5_b_im = args.in[8];
    const float* s5_c_re = args.in[9]; const float* s5_c_im = args.in[10]; const float* s5_d = args.in[11]; const float* s5_glu_w = args.in[12]; const float* s5_glu_b = args.in[13];
    const float* w_out_ab = args.in[14]; const float* w_in_c = args.in[15]; const float* conv_w = args.in[16]; const float* conv_b = args.in[17];
    const float* conv_ln_g = args.in[18]; const float* conv_ln_b = args.in[19]; const float* w_out_c = args.in[20];
    float* out = args.out;
    float* ss1 = (float*)(ws + WS_CTL);
    float* ropec = (float*)(ws + WS_ROPE); float* ropes = ropec + 4096 * 32;
    bf16* WinT = (bf16*)(ws + WS_WIN); bf16* WgluT = (bf16*)(ws + WS_WGLU); bf16* WoutT = (bf16*)(ws + WS_WOUT); bf16* WincT = (bf16*)(ws + WS_WINC); bf16* WoutcT = (bf16*)(ws + WS_WOUTC);
    bf16* Tg = (bf16*)(ws + WS_TG); bf16* Wg = (bf16*)(ws + WS_WG); float* L16 = (float*)(ws + WS_L16); float* KVseg = (float*)(ws + WS_KVSEG);
    bf16* XN = (bf16*)(ws + WS_XN); float* Sloc = (float*)(ws + WS_XN); bf16* Yg = (bf16*)(ws + WS_XN); bf16* XG2 = (bf16*)(ws + WS_XN);
    bf16* Aext = (bf16*)(ws + WS_AEXT); bf16* SG5 = (bf16*)(ws + WS_SG5); bf16* Qb = (bf16*)(ws + WS_Q); bf16* Kb = (bf16*)(ws + WS_K); bf16* Vb = (bf16*)(ws + WS_V); bf16* SGR = (bf16*)(ws + WS_SGR);
    float* X1 = (float*)(ws + WS_X1); bf16* U2 = (bf16*)(ws + WS_U2); bf16* SG2 = (bf16*)(ws + WS_SG2); bf16* V2 = (bf16*)(ws + WS_V2);
    bf16* Ymix = (bf16*)out;

    const int lo = args.ph_lo, hi = args.ph_hi;
#define IN(k) (lo <= (k) && (k) < hi)
#define SEAM(k) do { if (IN(k) && IN((k) + 1)) { cg::this_grid().sync(); } } while (0)

    if (IN(0)) {
        LAS float* scr = (LAS float*)(lds + wave * 16384);
        constexpr int I_IN = 16 * 160, I_GLU = 16 * 32, I_OUT = 32 * 32, I_INC = 16 * 96, I_OUTC = 16 * 32;
        constexpr int NITEMS = I_IN + I_GLU + I_OUT + I_INC + I_OUTC;
        for (int it = gw; it < NITEMS; it += NGW) {
            int r = it;
            if (r < I_IN) { p0_transpose_item(w_in_ab, 1024, 5120, WinT, 1, scr, r, lane); continue; } r -= I_IN;
            if (r < I_GLU) { p0_transpose_item(s5_glu_w, 1024, 1024, WgluT, 0, scr, r, lane); continue; } r -= I_GLU;
            if (r < I_OUT) { p0_transpose_item(w_out_ab, 2048, 1024, WoutT, 0, scr, r, lane); continue; } r -= I_OUT;
            if (r < I_INC) { p0_transpose_item(w_in_c, 1024, 3072, WincT, 2, scr, r, lane); continue; } r -= I_INC;
            p0_transpose_item(w_out_c, 1024, 1024, WoutcT, 0, scr, r, lane);
        }
        for (int e = bid * NTHR + tid; e < 4096 * 32; e += G * NTHR) { const int pos = e >> 5, f = e & 31;
            const double freq = exp(-(double)f * (9.210340371976182736 / 32.0)); const double ang = (double)pos * freq; const double tw = 6.283185307179586476925286766559;
            const float red = (float)(ang - tw * __builtin_rint(ang / tw)); ropec[e] = cosf(red); ropes[e] = sinf(red); }
        __syncthreads();
        for (int it = bid; it < 1024; it += G) s5_tables_item(it, (LAS float*)lds, s5_a_re, s5_a_im, s5_log_dt, s5_b_re, s5_b_im, s5_c_re, s5_c_im, s5_d, Tg, Wg, L16, tid);
        for (int m = gw; m < M; m += NGW) rms_row_to_bf16(x + (size_t)m * DM, norm_g, XN + (size_t)m * DM, lane);
    }
    SEAM(0);
    if (IN(1)) {
        pg8::Gemm g{XN, WinT, 1024, 1024, 1024, 0, 0}; pg8::StaticOrder S; S.init(M, 5120, G, bid);
        EpiWin E{Aext, SG5, Qb, Kb, Vb, SGR, ropec, ropes};
        pg8::gemm_phase<EpiWin, pg8::StaticOrder, true, false>(lds, g, S, E);
    }
    SEAM(1);
    if (IN(2)) {
        pg8::Gemm g{Aext, Wg, 256, AEXT_LD, 256, 0, 0}; pg8::GroupOrder S{G, bid};
        EpiSloc E{Sloc};
        pg8::gemm_phase<EpiSloc, pg8::GroupOrder, true, true>(lds, g, S, E);
        for (int it = bid; it < 256; it += G) { if ((it & 3) != 3) retention_item<false>(it, lds, Qb, Kb, Vb, SGR, KVseg, Ymix, tid); }
    }
    SEAM(2);
    if (IN(3)) { for (int it = bid; it < 512; it += G) s5_scan_item(it, (LAS float*)lds, Sloc, L16, Aext, tid); }
    SEAM(3);
    if (IN(4)) {
        pg8::Gemm g{Aext, Tg, AEXT_LD, AEXT_LD, AEXT_LD, 0, 0}; pg8::GroupOrder S{G, bid};
        EpiYg E{Yg};
        pg8::gemm_phase<EpiYg, pg8::GroupOrder, true, false>(lds, g, S, E);
        for (int it = bid; it < 256; it += G) retention_item<true>(it, lds, Qb, Kb, Vb, SGR, KVseg, Ymix, tid);
    }
    SEAM(4);
    if (IN(5)) {
        pg8::Gemm g{Yg, WgluT, 1024, 0, 1024, 1, M}; pg8::StaticOrder S; S.init(M, 1024, G, bid);
        EpiGlu E{Yg, SG5, s5_glu_b, Ymix};
        pg8::gemm_phase<EpiGlu, pg8::StaticOrder, true, false>(lds, g, S, E);
    }
    SEAM(5);
    if (IN(6)) {
        pg8::Gemm g{Ymix, WoutT, 2048, 2048, 2048, 0, 0}; pg8::StaticOrder S; S.init(M, 1024, G, bid);
        EpiWout E{x, X1, XG2, norm_g + 1024, ss1};
        pg8::gemm_phase<EpiWout, pg8::StaticOrder, true, false>(lds, g, S, E);
    }
    SEAM(6);
    if (IN(7)) {
        pg8::Gemm g{XG2, WincT, 1024, 1024, 1024, 0, 0}; pg8::StaticOrder S; S.init(M, 3072, G, bid);
        EpiWinC E{ss1, U2, SG2};
        pg8::gemm_phase<EpiWinC, pg8::StaticOrder, true, false>(lds, g, S, E);
    }
    SEAM(7);
    if (IN(8)) { for (int it = bid; it < 1024; it += G) conv_item(it, lds, U2, SG2, conv_w, conv_b, conv_ln_g, conv_ln_b, V2, tid); }
    SEAM(8);
    if (IN(9)) {
        pg8::Gemm g{V2, WoutcT, 1024, 1024, 1024, 0, 0}; pg8::StaticOrder S; S.init(M, 1024, G, bid);
        EpiWoutC E{X1, out};
        pg8::gemm_phase<EpiWoutC, pg8::StaticOrder, true, false>(lds, g, S, E);
    }
    SEAM(9);
    if (IN(10)) { for (int m = gw; m < M; m += NGW) rms_row_f32(out + (size_t)m * DM, final_g, lane); }
#undef IN
#undef SEAM
}

extern "C" void kernel_launch(void* const* d_in, const int* in_sizes, int n_in, void* d_out, int out_size, void* d_ws, size_t ws_size, hipStream_t stream) {
    static int grid = 0;
    if (grid == 0) {
        if (n_in != 21 || out_size != M * DM || ws_size < WS_END) { fprintf(stderr, "kernel_launch: unexpected shapes (n_in %d, out %d, ws %zu)\n", n_in, out_size, ws_size); grid = -1; return; }
        int dev = 0, cus = 0, per_cu = 0;
        if (hipGetDevice(&dev) != hipSuccess || hipDeviceGetAttribute(&cus, hipDeviceAttributeMultiprocessorCount, dev) != hipSuccess) { grid = -1; return; }
        if (hipFuncSetAttribute((const void*)fwd_megakernel, hipFuncAttributeMaxDynamicSharedMemorySize, LDS_BYTES) != hipSuccess) { fprintf(stderr, "kernel_launch: hipFuncSetAttribute failed\n"); grid = -1; return; }
        if (hipOccupancyMaxActiveBlocksPerMultiprocessor(&per_cu, (const void*)fwd_megakernel, NTHR, LDS_BYTES) != hipSuccess || per_cu < 1) { fprintf(stderr, "kernel_launch: occupancy query says %d\n", per_cu); per_cu = 1; }
        (void)hipGetLastError();
        grid = cus;
    }
    if (grid < 0) return;
    (void)hipMemsetAsync((char*)d_ws + WS_CTL, 0, CTL_ZERO_BYTES, stream);
    Args a{};
    for (int i = 0; i < 21; ++i) a.in[i] = (const float*)d_in[i];
    a.out = (float*)d_out; a.ws = (unsigned char*)d_ws;
#if MK_PER_PHASE
    for (int p = 0; p < N_PHASES; ++p) { a.ph_lo = p; a.ph_hi = p + 1; hipLaunchKernelGGL(fwd_megakernel, dim3(grid), dim3(NTHR), LDS_BYTES, stream, a); }
#else
    a.ph_lo = 0; a.ph_hi = N_PHASES;
    void* kargs[] = {&a};
    hipError_t e = hipLaunchCooperativeKernel((const void*)fwd_megakernel, dim3(grid), dim3(NTHR), kargs, LDS_BYTES, stream);
    if (e != hipSuccess) fprintf(stderr, "kernel_launch: cooperative launch failed: %s (grid %d)\n", hipGetErrorString(e), grid);
#endif
}
```

```cpp
#include <hip/hip_runtime.h>
#include <hip/hip_cooperative_groups.h>
#include <cstdio>
#include <cstdint>
namespace cg = cooperative_groups;

namespace pg8 {
#define PG8_LAS __attribute__((address_space(3)))
typedef unsigned short bf16_t;
typedef short bf16x8 __attribute__((ext_vector_type(8)));
typedef float f32x4 __attribute__((ext_vector_type(4)));
typedef float f32x2 __attribute__((ext_vector_type(2)));
typedef unsigned u32x4 __attribute__((ext_vector_type(4)));
typedef unsigned u32x2 __attribute__((ext_vector_type(2)));
constexpr int BM = 256, BK = 64, HALF = 128, HTB = HALF * BK * 2  , STAGE_BYTES = 8 * HTB, NXCD = 8, WGM = 8;

__host__ __device__ __forceinline__ int lds_byte(int r, int c) { const int st = (r >> 4) * 2 + (c >> 5), rr = r & 15, cc = c & 31, ob = rr * 64 + cc * 2; return st * 1024 + (ob ^ (((ob >> 9) & 1) << 5)); }
__host__ __device__ __forceinline__ void stage_rc(int b, int& R, int& C) { const int st = b / 1024, sb = b % 1024, swz = sb ^ (((sb >> 9) & 1) << 5); R = (st >> 1) * 16 + swz / 64; C = (st & 1) * 32 + (swz % 64) / 2; }
__host__ __device__ __forceinline__ int perm32(int rho) { const int n = rho >> 4, i = rho & 15; return 8 * (i >> 2) + 4 * n + (i & 3); }

struct Unit { int pm, pn; };
struct Gemm { const bf16_t* A; const bf16_t* Bt; int K, lda, ldb, amode, gM; };

struct StaticOrder {
    int nM, nN, nwg, G, c;
    __host__ __device__ void init(int M, int N, int G_, int c_) { nM = M / BM; nN = N / BM; nwg = nM * nN; G = G_; c = c_; }
    __host__ __device__ bool next(int i, Unit& u) const {
        const long L = (long)i * G + c; if (L >= nwg) return false;
        int wgid = (int)L; { const int q = nwg / NXCD, r = nwg % NXCD, xcd = wgid % NXCD, off = wgid / NXCD; wgid = (xcd < r ? xcd * (q + 1) : r * (q + 1) + (xcd - r) * q) + off; }
        const int nig = WGM * nN, gid = wgid / nig, fm = gid * WGM, gsz = (nM - fm) < WGM ? (nM - fm) : WGM;
        u.pm = fm + ((wgid % nig) % gsz); u.pn = (wgid % nig) / gsz; return true;
    }
};
struct GroupOrder {
    int G, c;
    __host__ __device__ bool next(int i, Unit& u) const { const int L = i * G + c; if (L >= 512) return false; u.pm = L; u.pn = L >> 3; return true; }
};

__device__ __forceinline__ unsigned cvt_pk_bf16(float lo, float hi) { unsigned r; asm volatile("v_cvt_pk_bf16_f32 %0, %1, %2" : "=v"(r) : "v"(lo), "v"(hi)); return r; }

template <class Epi, class Sched, bool ALIGN_EPI, bool SKIPB1>
__device__ __forceinline__ void gemm_phase(PG8_LAS unsigned char* lds, const Gemm g, const Sched& S, const Epi& E) {
    const int tid = threadIdx.x, wid = __builtin_amdgcn_readfirstlane(tid >> 6), lane = tid & 63, wr = wid >> 2, wc = wid & 3, fr = lane & 15, fq = lane >> 4;
    const int K = g.K, nt = K / BK;
    unsigned voffA[2], voffB[2];
#pragma unroll
    for (int i = 0; i < 2; ++i) { int R, C; stage_rc(tid * 16 + i * 8192, R, C); const int Rb = Epi::PERM ? ((R & ~31) + perm32(R & 31)) : R;
        voffA[i] = g.amode ? (unsigned)(((C >> 4) * g.gM + R) * 16 + (C & 15)) * 2u : (unsigned)(R * g.lda + C) * 2u;
        voffB[i] = (unsigned)(Rb * g.ldb + C) * 2u; }
    const size_t kstepA = g.amode ? (size_t)g.gM * 128 : (size_t)(BK * 2);
    const size_t kstepB = (size_t)(BK * 2);
    const size_t hstepA = g.amode ? (size_t)HALF * 32 : (size_t)HALF * g.lda * 2;
    const size_t hstepB = (size_t)HALF * g.ldb * 2;
    const size_t tstepA = 2 * hstepA, tstepB = 2 * hstepB;
    const unsigned ldsw = (unsigned)wid * 1024u;
    const int aoff = lds_byte(wr * 64 + fr, fq * 8), boff = lds_byte(wc * 32 + fr, fq * 8);
#define PG8_SA(b, h) (((b) * 2 + (h)) * HTB)
#define PG8_SB(b, h) ((4 + (b) * 2 + (h)) * HTB)
#define PG8_STAGE(bufoff, gbase, voff) do { _Pragma("unroll") for (int _i = 0; _i < 2; ++_i) \
        __builtin_amdgcn_global_load_lds((const unsigned*)((const char*)(gbase) + (voff)[_i]), (PG8_LAS unsigned*)(lds + (bufoff) + ldsw + _i * 8192), 16, 0, 0); } while (0)
#define PG8_LDA(dst, b, h) do { _Pragma("unroll") for (int m = 0; m < 4; ++m) _Pragma("unroll") for (int k = 0; k < 2; ++k) dst[m][k] = *(const PG8_LAS bf16x8*)(lds + PG8_SA(b, h) + aoff + m * 2048 + k * 1024); } while (0)
#define PG8_LDB(dst, b, h) do { _Pragma("unroll") for (int n = 0; n < 2; ++n) _Pragma("unroll") for (int k = 0; k < 2; ++k) dst[n][k] = *(const PG8_LAS bf16x8*)(lds + PG8_SB(b, h) + boff + n * 2048 + k * 1024); } while (0)
#define PG8_MMA(ai, bj, At, Bt) do { __builtin_amdgcn_s_setprio(1); _Pragma("unroll") for (int m = 0; m < 4; ++m) _Pragma("unroll") for (int n = 0; n < 2; ++n) _Pragma("unroll") for (int k = 0; k < 2; ++k) \
        acc[ai][bj][m][n] = __builtin_amdgcn_mfma_f32_16x16x32_bf16(Bt[n][k], At[m][k], acc[ai][bj][m][n], 0, 0, 0); __builtin_amdgcn_s_setprio(0); } while (0)
#define PG8_MMA1(ai, At, Bt) do { if constexpr (!SKIPB1) PG8_MMA(ai, 1, At, Bt); } while (0)
#define PG8_WAIT_V(n) asm volatile("s_waitcnt vmcnt(" #n ")" ::: "memory")
#define PG8_WAIT_L(n) asm volatile("s_waitcnt lgkmcnt(" #n ")" ::: "memory")
#define PG8_BAR __builtin_amdgcn_s_barrier()
#define PG8_SCHED __builtin_amdgcn_sched_barrier(0)
    Unit cur, nxt; int ui = 0;
    if (!S.next(0, cur)) return;
    f32x4 acc[2][2][4][2];
#pragma unroll
    for (int a = 0; a < 2; ++a)
#pragma unroll
        for (int b = 0; b < 2; ++b)
#pragma unroll
            for (int m = 0; m < 4; ++m)
#pragma unroll
                for (int n = 0; n < 2; ++n) acc[a][b][m][n] = (f32x4){0.f, 0.f, 0.f, 0.f};
    bf16x8 At[4][2], B0[2][2], B1[2][2];
    const char* cA = (const char*)g.A + (size_t)cur.pm * tstepA; const char* cB = (const char*)g.Bt + (size_t)cur.pn * tstepB;
    PG8_STAGE(PG8_SB(0, 0), cB, voffB); PG8_STAGE(PG8_SB(0, 1), cB + hstepB, voffB); PG8_STAGE(PG8_SA(0, 0), cA, voffA); PG8_STAGE(PG8_SA(0, 1), cA + hstepA, voffA);
    if (wr == 1) PG8_BAR;
    PG8_WAIT_V(2); PG8_BAR;
    PG8_STAGE(PG8_SB(1, 0), cB + kstepB, voffB); PG8_STAGE(PG8_SA(1, 0), cA + kstepA, voffA); PG8_STAGE(PG8_SB(1, 1), cB + hstepB + kstepB, voffB);
    PG8_WAIT_V(6); PG8_BAR;
    for (;;) {
        const bool has_next = S.next(ui + 1, nxt);
        const char* nA = has_next ? (const char*)g.A + (size_t)nxt.pm * tstepA : cA; const char* nB = has_next ? (const char*)g.Bt + (size_t)nxt.pn * tstepB : cB;
        for (int t = 0; t < nt; t += 2) {
            const bool last = (t == nt - 2);
            const char* a1 = cA + (size_t)(t + 1) * kstepA;
            const char* a2 = last ? nA : cA + (size_t)(t + 2) * kstepA; const char* b2 = last ? nB : cB + (size_t)(t + 2) * kstepB;
            const char* a3 = a2 + kstepA; const char* b3 = b2 + kstepB;
            PG8_LDB(B0, 0, 0); PG8_LDB(B1, 0, 1); PG8_SCHED; PG8_LDA(At, 0, 0); PG8_STAGE(PG8_SA(1, 1), a1 + hstepA, voffA);
            PG8_WAIT_V(8); PG8_WAIT_L(0); PG8_BAR; PG8_MMA(0, 0, At, B0); PG8_MMA1(0, At, B1); PG8_BAR; PG8_SCHED;
            PG8_LDA(At, 0, 1); PG8_STAGE(PG8_SB(0, 0), b2, voffB); PG8_STAGE(PG8_SB(0, 1), b2 + hstepB, voffB); PG8_STAGE(PG8_SA(0, 0), a2, voffA);
            PG8_WAIT_V(8); PG8_WAIT_L(0); PG8_BAR; PG8_MMA(1, 0, At, B0); PG8_MMA1(1, At, B1); PG8_BAR; PG8_SCHED;
            PG8_LDB(B0, 1, 0); PG8_LDB(B1, 1, 1); PG8_SCHED; PG8_LDA(At, 1, 0); PG8_STAGE(PG8_SA(0, 1), a2 + hstepA, voffA);
            PG8_WAIT_V(8); PG8_WAIT_L(0); PG8_BAR; PG8_MMA(0, 0, At, B0); PG8_MMA1(0, At, B1); PG8_BAR; PG8_SCHED;
            PG8_LDA(At, 1, 1); PG8_STAGE(PG8_SB(1, 0), b3, voffB); PG8_STAGE(PG8_SB(1, 1), b3 + hstepB, voffB); PG8_STAGE(PG8_SA(1, 0), a3, voffA);
            PG8_WAIT_V(8); PG8_WAIT_L(0); PG8_BAR; PG8_MMA(1, 0, At, B0); PG8_MMA1(1, At, B1); PG8_BAR; PG8_SCHED;
        }
        if constexpr (ALIGN_EPI) { if (wr == 0) PG8_BAR; }
        E(acc, cur, wr, wc, fr, fq);
        if (!has_next) break;
#pragma unroll
        for (int a = 0; a < 2; ++a)
#pragma unroll
            for (int b = 0; b < 2; ++b)
#pragma unroll
                for (int m = 0; m < 4; ++m)
#pragma unroll
                    for (int n = 0; n < 2; ++n) acc[a][b][m][n] = (f32x4){0.f, 0.f, 0.f, 0.f};
        cur = nxt; cA = nA; cB = nB; ++ui;
        if constexpr (ALIGN_EPI) { if (wr == 1) PG8_BAR; }
    }
    PG8_WAIT_V(0);
    if constexpr (!ALIGN_EPI) { if (wr == 0) PG8_BAR; }
    PG8_BAR;
#undef PG8_SA
#undef PG8_SB
#undef PG8_STAGE
#undef PG8_LDA
#undef PG8_LDB
#undef PG8_MMA
#undef PG8_MMA1
#undef PG8_WAIT_V
#undef PG8_WAIT_L
#undef PG8_BAR
#undef PG8_SCHED
}
}

#define GAS __attribute__((address_space(1)))
#define LAS __attribute__((address_space(3)))
typedef unsigned short bf16;
typedef pg8::f32x4 f32x4;
typedef pg8::f32x2 f32x2;
typedef pg8::u32x4 u32x4;
typedef pg8::u32x2 u32x2;
typedef pg8::bf16x8 bf16x8;
constexpr int NWAVES = 8, NTHR = 512;
constexpr int M = 32768, DM = 1024, SEQ = 4096;
constexpr float EPS = 1e-6f;
constexpr size_t MiB = 1u << 20;
constexpr size_t WS_CTL = 0, CTL_ZERO_BYTES = 1 * MiB;
constexpr size_t WS_ROPE = 1 * MiB;
constexpr size_t WS_WIN = 2 * MiB, WS_WGLU = 12 * MiB, WS_WOUT = 14 * MiB, WS_WINC = 18 * MiB, WS_WOUTC = 24 * MiB;
constexpr size_t WS_TG = 26 * MiB, WS_WG = 38 * MiB, WS_L16 = 46 * MiB, WS_KVSEG = 48 * MiB;
constexpr size_t WS_XN = 64 * MiB;
constexpr size_t WS_AEXT = 128 * MiB;
constexpr size_t WS_SG5 = 224 * MiB, WS_Q = 288 * MiB, WS_K = 320 * MiB, WS_V = 352 * MiB, WS_SGR = 416 * MiB;
constexpr size_t WS_X1 = 128 * MiB, WS_U2 = 256 * MiB, WS_SG2 = 320 * MiB, WS_V2 = 384 * MiB, WS_END = 480 * MiB;
constexpr int LDS_BYTES = 147456;
constexpr int AEXT_LD = 384;

__device__ __forceinline__ float fsigmoid(float x) { return __builtin_amdgcn_rcpf(1.0f + __expf(-x)); }
__device__ __forceinline__ float fsilu(float x) { return x * fsigmoid(x); }
__device__ __forceinline__ float fgelu_tanh(float x) { const float u = 1.5957691216f * (x + 0.044715f * x * x * x); return x * fsigmoid(u); }
__device__ __forceinline__ unsigned f2bf(float f) { unsigned u = __builtin_bit_cast(unsigned, f); return (u + 0x7fffu + ((u >> 16) & 1u)) >> 16; }
__device__ __forceinline__ float bf2f(unsigned h) { return __builtin_bit_cast(float, h << 16); }
__device__ __forceinline__ unsigned pk2(float lo, float hi) { return pg8::cvt_pk_bf16(lo, hi); }
__device__ __forceinline__ u32x4 pack8(f32x4 a, f32x4 b) { u32x4 w; w.x = pk2(a[0], a[1]); w.y = pk2(a[2], a[3]); w.z = pk2(b[0], b[1]); w.w = pk2(b[2], b[3]); return w; }
__device__ __forceinline__ void unpack8(u32x4 w, f32x4& a, f32x4& b) {
    a[0] = bf2f(w.x & 0xffffu); a[1] = bf2f(w.x >> 16); a[2] = bf2f(w.y & 0xffffu); a[3] = bf2f(w.y >> 16);
    b[0] = bf2f(w.z & 0xffffu); b[1] = bf2f(w.z >> 16); b[2] = bf2f(w.w & 0xffffu); b[3] = bf2f(w.w >> 16); }
__device__ __forceinline__ float wave_sum(float v) {
#pragma unroll
    for (int o = 1; o < 64; o <<= 1) v += __shfl_xor(v, o);
    return v;
}

typedef f32x4 AccT[2][2][4][2];

struct EpiWin {
    static constexpr bool PERM = true;
    bf16 *Aext, *SG5, *Q, *Kb, *V, *SGR; const float *ropec, *ropes;
    __device__ __forceinline__ void operator()(const AccT& acc, const pg8::Unit& u, int wr, int wc, int fr, int fq) const {
        const int pn = u.pn, row0 = u.pm * 256 + wr * 64 + fr;
#pragma unroll
        for (int ai = 0; ai < 2; ++ai)
#pragma unroll
            for (int m = 0; m < 4; ++m) { const int row = row0 + ai * 128 + m * 16;
#pragma unroll
                for (int bj = 0; bj < 2; ++bj) { const int colt = pn * 256 + bj * 128 + wc * 32 + 8 * fq;
                    f32x4 v0 = acc[ai][bj][m][0], v1 = acc[ai][bj][m][1];
                    if (pn < 4) {
                        const int g = colt >> 4, h0 = colt & 15;
                        bf16* dst = Aext + (size_t)g * (2048 * AEXT_LD) + (size_t)(row >> 4) * AEXT_LD + (row & 15) * 16 + h0;
                        *(u32x4*)dst = pack8(v0, v1);
                    } else if (pn < 8) {
#pragma unroll
                        for (int i = 0; i < 4; ++i) { v0[i] = fsilu(v0[i]); v1[i] = fsilu(v1[i]); }
                        *(u32x4*)(SG5 + (size_t)row * 1024 + (colt - 1024)) = pack8(v0, v1);
                    } else if (pn < 12) {
                        const bool isq = pn < 10; const int c = colt - (isq ? 2048 : 2560); const int j = (c & 63) >> 3; const int pos = row & (SEQ - 1);
                        const f32x4 cs = *(const f32x4*)(ropec + pos * 32 + 4 * j), sn = *(const f32x4*)(ropes + pos * 32 + 4 * j);
                        const float sc = isq ? 0.125f : 1.0f;
                        f32x4 o1 = (v0 * cs - v1 * sn) * sc, o2 = (v0 * sn + v1 * cs) * sc;
                        *(u32x4*)((isq ? Q : Kb) + (size_t)row * 512 + c) = pack8(o1, o2);
                    } else if (pn < 16) {
                        *(u32x4*)(V + (size_t)row * 1024 + (colt - 3072)) = pack8(v0, v1);
                    } else {
#pragma unroll
                        for (int i = 0; i < 4; ++i) { v0[i] = fsilu(v0[i]); v1[i] = fsilu(v1[i]); }
                        *(u32x4*)(SGR + (size_t)row * 1024 + (colt - 4096)) = pack8(v0, v1);
                    } } }
    }
};
struct EpiSloc {
    static constexpr bool PERM = false;
    float* O;
    __device__ __forceinline__ void operator()(const AccT& acc, const pg8::Unit& u, int wr, int wc, int fr, int fq) const {
        const int row0 = u.pm * 256 + wr * 64 + fr, col0 = wc * 32 + 4 * fq;
#pragma unroll
        for (int ai = 0; ai < 2; ++ai)
#pragma unroll
            for (int m = 0; m < 4; ++m) { float* rowp = O + (size_t)(row0 + ai * 128 + m * 16) * 128 + col0;
#pragma unroll
                for (int n = 0; n < 2; ++n) *(f32x4*)(rowp + 16 * n) = acc[ai][0][m][n]; }
    }
};
struct EpiYg {
    static constexpr bool PERM = true;
    bf16* O;
    __device__ __forceinline__ void operator()(const AccT& acc, const pg8::Unit& u, int wr, int wc, int fr, int fq) const {
        const int row0 = u.pm * 256 + wr * 64 + fr, col0 = wc * 32 + 8 * fq;
#pragma unroll
        for (int ai = 0; ai < 2; ++ai)
#pragma unroll
            for (int m = 0; m < 4; ++m) { bf16* rowp = O + (size_t)(row0 + ai * 128 + m * 16) * 256 + col0;
#pragma unroll
                for (int bj = 0; bj < 2; ++bj) { f32x4 v0 = acc[ai][bj][m][0], v1 = acc[ai][bj][m][1];
#pragma unroll
                    for (int i = 0; i < 4; ++i) { v0[i] = fgelu_tanh(v0[i]); v1[i] = fgelu_tanh(v1[i]); }
                    *(u32x4*)(rowp + bj * 128) = pack8(v0, v1); } }
    }
};
struct EpiGlu {
    static constexpr bool PERM = true;
    const bf16* Yg; const bf16* SG5; const float* bias; bf16* Ymix;
    __device__ __forceinline__ void operator()(const AccT& acc, const pg8::Unit& u, int wr, int wc, int fr, int fq) const {
        const int row0 = u.pm * 256 + wr * 64 + fr, colb = u.pn * 256 + wc * 32 + 8 * fq;
        f32x4 bv[2][2];
#pragma unroll
        for (int bj = 0; bj < 2; ++bj)
#pragma unroll
            for (int n = 0; n < 2; ++n) bv[bj][n] = *(const f32x4*)(bias + colb + bj * 128 + 4 * n);
#pragma unroll
        for (int ai = 0; ai < 2; ++ai)
#pragma unroll
            for (int m = 0; m < 4; ++m) { const int row = row0 + ai * 128 + m * 16;
#pragma unroll
                for (int bj = 0; bj < 2; ++bj) { const int c = colb + bj * 128;
                    const u32x4 yw = *(const u32x4*)(Yg + ((size_t)(c >> 4) * M + row) * 16 + (c & 15));
                    const u32x4 gw = *(const u32x4*)(SG5 + (size_t)row * 1024 + c);
                    f32x4 y0, y1, g0, g1; unpack8(yw, y0, y1); unpack8(gw, g0, g1);
                    f32x4 z0 = acc[ai][bj][m][0] + bv[bj][0], z1 = acc[ai][bj][m][1] + bv[bj][1];
#pragma unroll
                    for (int i = 0; i < 4; ++i) { z0[i] = y0[i] * fsigmoid(z0[i]) * g0[i]; z1[i] = y1[i] * fsigmoid(z1[i]) * g1[i]; }
                    *(u32x4*)(Ymix + (size_t)row * 2048 + c) = pack8(z0, z1); }
                asm volatile("" ::: "memory"); }
    }
};
struct EpiWout {
    static constexpr bool PERM = false;
    const float* X; float* X1; bf16* XG2; const float* g1; float* ss1;
    __device__ __forceinline__ void operator()(const AccT& acc, const pg8::Unit& u, int wr, int wc, int fr, int fq) const {
        const int row0 = u.pm * 256 + wr * 64 + fr, colb = u.pn * 256 + wc * 32 + 4 * fq;
        f32x4 gv[2][2];
#pragma unroll
        for (int bj = 0; bj < 2; ++bj)
#pragma unroll
            for (int n = 0; n < 2; ++n) gv[bj][n] = *(const f32x4*)(g1 + colb + bj * 128 + 16 * n);
#pragma unroll
        for (int ai = 0; ai < 2; ++ai)
#pragma unroll
            for (int m = 0; m < 4; ++m) { const int row = row0 + ai * 128 + m * 16; const size_t off = (size_t)row * 1024 + colb; float s = 0.f;
#pragma unroll
                for (int bj = 0; bj < 2; ++bj)
#pragma unroll
                    for (int n = 0; n < 2; ++n) { const f32x4 xv = *(const f32x4*)(X + off + bj * 128 + 16 * n); const f32x4 x1 = xv + acc[ai][bj][m][n];
                        *(f32x4*)(X1 + off + bj * 128 + 16 * n) = x1; s += (x1[0] * x1[0] + x1[1] * x1[1]) + (x1[2] * x1[2] + x1[3] * x1[3]);
                        const f32x4 xg = x1 * gv[bj][n]; u32x2 w; w.x = pk2(xg[0], xg[1]); w.y = pk2(xg[2], xg[3]); *(u32x2*)(XG2 + off + bj * 128 + 16 * n) = w; }
                s += __shfl_xor(s, 16); s += __shfl_xor(s, 32);
                if (fq == 0) atomicAdd(ss1 + row, s);
                asm volatile("" ::: "memory"); }
    }
};
struct EpiWinC {
    static constexpr bool PERM = true;
    const float* ss1; bf16* U2; bf16* SG2;
    __device__ __forceinline__ void operator()(const AccT& acc, const pg8::Unit& u, int wr, int wc, int fr, int fq) const {
        const int pn = u.pn, row0 = u.pm * 256 + wr * 64 + fr;
#pragma unroll
        for (int ai = 0; ai < 2; ++ai)
#pragma unroll
            for (int m = 0; m < 4; ++m) { const int row = row0 + ai * 128 + m * 16; const float r = rsqrtf(ss1[row] * (1.0f / 1024.0f) + EPS);
                if (pn < 8) {
                    f32x4 a0 = acc[ai][0][m][0] * r, a1 = acc[ai][0][m][1] * r, b0 = acc[ai][1][m][0] * r, b1 = acc[ai][1][m][1] * r;
#pragma unroll
                    for (int i = 0; i < 4; ++i) { a0[i] *= fsigmoid(b0[i]); a1[i] *= fsigmoid(b1[i]); }
                    *(u32x4*)(U2 + (size_t)row * 1024 + pn * 128 + wc * 32 + 8 * fq) = pack8(a0, a1);
                } else {
#pragma unroll
                    for (int bj = 0; bj < 2; ++bj) { f32x4 v0 = acc[ai][bj][m][0] * r, v1 = acc[ai][bj][m][1] * r;
#pragma unroll
                        for (int i = 0; i < 4; ++i) { v0[i] = fsilu(v0[i]); v1[i] = fsilu(v1[i]); }
                        *(u32x4*)(SG2 + (size_t)row * 1024 + (pn - 8) * 256 + bj * 128 + wc * 32 + 8 * fq) = pack8(v0, v1); }
                } }
    }
};
struct EpiWoutC {
    static constexpr bool PERM = false;
    const float* X1; float* O;
    __device__ __forceinline__ void operator()(const AccT& acc, const pg8::Unit& u, int wr, int wc, int fr, int fq) const {
        const int row0 = u.pm * 256 + wr * 64 + fr, colb = u.pn * 256 + wc * 32 + 4 * fq;
#pragma unroll
        for (int ai = 0; ai < 2; ++ai)
#pragma unroll
            for (int m = 0; m < 4; ++m) { const size_t off = (size_t)(row0 + ai * 128 + m * 16) * 1024 + colb;
#pragma unroll
                for (int bj = 0; bj < 2; ++bj)
#pragma unroll
                    for (int n = 0; n < 2; ++n) { const f32x4 xv = *(const f32x4*)(X1 + off + bj * 128 + 16 * n); *(f32x4*)(O + off + bj * 128 + 16 * n) = xv + acc[ai][bj][m][n]; }
                asm volatile("" ::: "memory"); }
    }
};

#define LDS_WAIT() asm volatile("s_waitcnt lgkmcnt(0)" ::: "memory")
__device__ __forceinline__ int dest_row(int n, int mode) {
    if (mode == 1) { if (n >= 2048 && n < 3072) { const int d = n & 63; return (n & ~63) + 8 * ((d & 31) >> 2) + 4 * (d >> 5) + (d & 3); } return n; }
    if (mode == 2) { if (n < 1024) return 256 * (n >> 7) + (n & 127); if (n < 2048) { const int q = n - 1024; return 256 * (q >> 7) + 128 + (q & 127); } return n; }
    return n;
}
__device__ __forceinline__ void p0_transpose_item(const float* W, int K, int N, bf16* WT, int mode, LAS float* scr, int item, int lane) {
    const int nblk = N / 32, kb = item / nblk, nb = item % nblk, k0 = 64 * kb, n0 = 32 * nb;
#pragma unroll 8
    for (int i = 0; i < 32; ++i) { const int kk = 2 * i + (lane >> 5); scr[kk * 33 + (lane & 31)] = W[(size_t)(k0 + kk) * N + n0 + (lane & 31)]; }
    LDS_WAIT(); asm volatile("" ::: "memory");
    const int c = lane & 7;
#pragma unroll
    for (int j = 0; j < 4; ++j) { const int n = (lane >> 3) + 8 * j; const LAS float* s = scr + (8 * c) * 33 + n;
        u32x4 o; o.x = pk2(s[0 * 33], s[1 * 33]); o.y = pk2(s[2 * 33], s[3 * 33]); o.z = pk2(s[4 * 33], s[5 * 33]); o.w = pk2(s[6 * 33], s[7 * 33]);
        *(u32x4*)(WT + (size_t)dest_row(n0 + n, mode) * K + k0 + 8 * c) = o; }
    LDS_WAIT(); asm volatile("" ::: "memory");
}
__device__ __forceinline__ void rms_row_to_bf16(const float* xrow, const float* g, bf16* orow, int lane) {
    const f32x4* xr = (const f32x4*)xrow + lane; const f32x4* gr = (const f32x4*)g + lane;
    f32x4 v[4]; float s = 0.f;
#pragma unroll
    for (int j = 0; j < 4; ++j) { v[j] = xr[64 * j]; s += (v[j][0] * v[j][0] + v[j][1] * v[j][1]) + (v[j][2] * v[j][2] + v[j][3] * v[j][3]); }
    const float r = rsqrtf(wave_sum(s) * (1.f / 1024.f) + EPS);
    u32x2* o8 = (u32x2*)orow + lane;
#pragma unroll
    for (int j = 0; j < 4; ++j) { const f32x4 gg = gr[64 * j]; u32x2 w; w.x = pk2(v[j][0] * r * gg[0], v[j][1] * r * gg[1]); w.y = pk2(v[j][2] * r * gg[2], v[j][3] * r * gg[3]); o8[64 * j] = w; }
}
__device__ __forceinline__ void rms_row_f32(float* xrow, const float* g, int lane) {
    f32x4* xr = (f32x4*)xrow + lane; const f32x4* gr = (const f32x4*)g + lane;
    f32x4 v[4]; float s = 0.f;
#pragma unroll
    for (int j = 0; j < 4; ++j) { v[j] = xr[64 * j]; s += (v[j][0] * v[j][0] + v[j][1] * v[j][1]) + (v[j][2] * v[j][2] + v[j][3] * v[j][3]); }
    const float r = rsqrtf(wave_sum(s) * (1.f / 1024.f) + EPS);
#pragma unroll
    for (int j = 0; j < 4; ++j) xr[64 * j] = v[j] * r * gr[64 * j];
}

__device__ __forceinline__ void cpow_table(float rho, float theta, int k, float& pr, float& pi) {
    const float mag = __expf(rho * (float)k);
    const double ang = (double)theta * (double)k; const double tw = 6.283185307179586476925286766559;
    const float red = (float)(ang - tw * __builtin_rint(ang / tw));
    pr = mag * cosf(red); pi = mag * sinf(red);
}
__device__ __forceinline__ void s5_tables_item(int item, LAS float* L, const float* a_re, const float* a_im, const float* log_dt, const float* b_re, const float* b_im,
                                               const float* c_re, const float* c_im, const float* dskip, bf16* Tg, bf16* Wg, float* L16, int tid) {
    const int g = item >> 4, k = item & 15;
    LAS float* Lkr = L; LAS float* Lki = L + 64; LAS float* L1r = L + 128; LAS float* L1i = L + 192; LAS float* cfr = L + 256; LAS float* cfi = L + 320;
    LAS float* Bbr = L + 384; LAS float* Bbi = Bbr + 1024; LAS float* Cr = Bbi + 1024; LAS float* Ci = Cr + 1024; LAS float* Kk = Ci + 1024;
    if (tid < 64) { const int n = tid; const float are = a_re[g * 64 + n], aim = a_im[g * 64 + n], dt = expf(log_dt[g]);
        const float rho = are * dt, theta = aim * dt;
        float lr, li; cpow_table(rho, theta, 1, lr, li);
        const float mag = expf(rho); const float sh = sinf(0.5f * theta);
        const float nr = expm1f(rho) * cosf(theta) - 2.0f * sh * sh, ni = li; (void)mag; (void)lr;
        const float den = are * are + aim * aim;
        cfr[n] = (nr * are + ni * aim) / den; cfi[n] = (ni * are - nr * aim) / den;
        float pr, pi; cpow_table(rho, theta, k, pr, pi); Lkr[n] = pr; Lki[n] = pi;
        cpow_table(rho, theta, k + 1, pr, pi); L1r[n] = pr; L1i[n] = pi;
        if (k == 15) { L16[g * 128 + n] = pr; L16[g * 128 + 64 + n] = pi; }
    }
    for (int e = tid; e < 1024; e += NTHR) { Cr[e] = c_re[g * 1024 + e]; Ci[e] = c_im[g * 1024 + e]; }
    __syncthreads();
    for (int e = tid; e < 1024; e += NTHR) { const int n = e >> 4; const float br = b_re[g * 1024 + e], bi = b_im[g * 1024 + e];
        Bbr[e] = cfr[n] * br - cfi[n] * bi; Bbi[e] = cfr[n] * bi + cfi[n] * br; }
    __syncthreads();
    if (tid < 256) { const int ho = tid >> 4, hi = tid & 15; float s = 0.f;
        for (int n = 0; n < 64; ++n) { const float clr = Cr[ho * 64 + n] * Lkr[n] - Ci[ho * 64 + n] * Lki[n], cli = Cr[ho * 64 + n] * Lki[n] + Ci[ho * 64 + n] * Lkr[n];
            s += clr * Bbr[n * 16 + hi] - cli * Bbi[n * 16 + hi]; }
        if (k == 0 && ho == hi) s += dskip[g * 16 + ho];
        Kk[tid] = s; }
    __syncthreads();
    bf16* Tgg = Tg + (size_t)g * 256 * AEXT_LD;
    {
        const int bi = tid >> 5, ho = (tid & 31) >> 1, h8 = (tid & 1) * 8;
        if (bi >= k) { const int to = bi, ti = bi - k; const LAS float* s = Kk + ho * 16 + h8;
            u32x4 w; w.x = pk2(s[0], s[1]); w.y = pk2(s[2], s[3]); w.z = pk2(s[4], s[5]); w.w = pk2(s[6], s[7]);
            *(u32x4*)(Tgg + (size_t)(to * 16 + ho) * AEXT_LD + ti * 16 + h8) = w; }
        if (k >= 1 && bi + k <= 15) { const int to = bi, ti = bi + k; *(u32x4*)(Tgg + (size_t)(to * 16 + ho) * AEXT_LD + ti * 16 + h8) = (u32x4){0u, 0u, 0u, 0u}; }
    }
    for (int e = tid; e < 1024; e += NTHR) { const int ho = e >> 6, n = e & 63;
        const float vr = Cr[e] * L1r[n] - Ci[e] * L1i[n], vi = Cr[e] * L1i[n] + Ci[e] * L1r[n];
        bf16* rowp = Tgg + (size_t)(k * 16 + ho) * AEXT_LD + 256;
        rowp[n] = (bf16)f2bf(vr); rowp[64 + n] = (bf16)f2bf(-vi); }
    {
        const int np = tid >> 1, h8 = (tid & 1) * 8, ti = 15 - k; float v[8];
#pragma unroll
        for (int x = 0; x < 8; ++x) { float val = 0.f;
            if (np < 128) { const int n = np & 63; const float br = Bbr[n * 16 + h8 + x], bi2 = Bbi[n * 16 + h8 + x];
                val = np < 64 ? (Lkr[n] * br - Lki[n] * bi2) : (Lkr[n] * bi2 + Lki[n] * br); }
            v[x] = val; }
        u32x4 w; w.x = pk2(v[0], v[1]); w.y = pk2(v[2], v[3]); w.z = pk2(v[4], v[5]); w.w = pk2(v[6], v[7]);
        *(u32x4*)(Wg + ((size_t)g * 256 + np) * 256 + ti * 16 + h8) = w;
    }
    __syncthreads();
}

__device__ __forceinline__ void s5_scan_item(int item, LAS float* L, const float* Sloc, const float* L16, bf16* Aext, int tid) {
    const int g = item >> 3, b = item & 7, seg = tid >> 6, n = tid & 63;
    const float ar = L16[g * 128 + n], ai = L16[g * 128 + 64 + n];
    const float* sl = Sloc + (size_t)(g * 2048 + b * 256 + seg * 32) * 128 + n;
    float er = 0.f, ei = 0.f;
#pragma unroll 8
    for (int c = 0; c < 32; ++c) { const float sr = sl[c * 128], si = sl[c * 128 + 64]; const float t = ar * er - ai * ei + sr; ei = ar * ei + ai * er + si; er = t; }
    float pr = ar, pi = ai;
#pragma unroll
    for (int i = 0; i < 5; ++i) { const float t = pr * pr - pi * pi; pi = 2.f * pr * pi; pr = t; }
    L[(seg * 64 + n) * 2] = er; L[(seg * 64 + n) * 2 + 1] = ei;
    __syncthreads();
    float xr = 0.f, xi = 0.f;
    for (int s = 0; s < seg; ++s) { const float qr = L[(s * 64 + n) * 2], qi = L[(s * 64 + n) * 2 + 1]; const float t = pr * xr - pi * xi + qr; xi = pr * xi + pi * xr + qi; xr = t; }
    bf16* dst = Aext + (size_t)(g * 2048 + b * 256 + seg * 32) * AEXT_LD + 256 + n;
#pragma unroll 8
    for (int c = 0; c < 32; ++c) { const float sr = sl[c * 128], si = sl[c * 128 + 64];
        dst[c * AEXT_LD] = (bf16)f2bf(xr); dst[c * AEXT_LD + 64] = (bf16)f2bf(xi);
        const float t = ar * xr - ai * xi + sr; xi = ar * xi + ai * xr + si; xr = t; }
    __syncthreads();
}

typedef short s16x4 __attribute__((ext_vector_type(4)));
constexpr int RP = 72, RPV = 152;
__device__ __forceinline__ bf16x8 tr_frag8(LAS bf16* p0, int pitch) {
    const s16x4 a = __builtin_amdgcn_ds_read_tr16_b64_v4i16((LAS s16x4*)p0);
    const s16x4 b = __builtin_amdgcn_ds_read_tr16_b64_v4i16((LAS s16x4*)(p0 + 4 * pitch));
    return (bf16x8){a[0], a[1], a[2], a[3], b[0], b[1], b[2], b[3]};
}
template <bool FULL>
__device__ __forceinline__ void retention_item(int item, LAS unsigned char* lds, const bf16* Q, const bf16* Kb, const bf16* V, const bf16* SGR, float* KVseg, bf16* Ymix, int tid) {
    const int b = item >> 5, h = (item >> 2) & 7, seg = item & 3;
    const int wid = tid >> 6, lane = tid & 63, l15 = lane & 15, q4 = lane >> 4, tq = (lane & 15) >> 2, tp = lane & 3;
    LAS bf16* Qs = (LAS bf16*)lds; LAS bf16* Ks = Qs + 64 * RP; LAS bf16* KPs = Ks + 64 * RP; LAS bf16* Vs = KPs + 64 * RP;
    LAS bf16* Ps = Vs + 64 * RPV; LAS bf16* STs = Ps + 64 * RP; LAS float* stat = (LAS float*)(STs + 128 * RP);
    const float lg2 = log2f(1.0f - exp2f(-5.0f - (float)h));
    const float d64 = exp2f(lg2 * 64.0f);
    const int db = wid >> 1, ib = wid >> 1, hf = wid & 1, et0 = hf * 4;
    f32x4 Sacc[4];
#pragma unroll
    for (int t = 0; t < 4; ++t) Sacc[t] = (f32x4){0.f, 0.f, 0.f, 0.f};
    if (FULL) {
        const float w1024 = exp2f(lg2 * 1024.0f); float wgt = 1.0f;
        for (int s = seg - 1; s >= 0; --s) { const float* kv = KVseg + (size_t)((b * 8 + h) * 4 + s) * 8192;
#pragma unroll
            for (int t = 0; t < 4; ++t)
#pragma unroll
                for (int r = 0; r < 4; ++r) Sacc[t][r] += wgt * kv[(db * 16 + 4 * q4 + r) * 128 + (et0 + t) * 16 + l15];
            wgt *= w1024; }
#pragma unroll
        for (int t = 0; t < 4; ++t) { u32x2 w; w.x = pk2(Sacc[t][0], Sacc[t][1]); w.y = pk2(Sacc[t][2], Sacc[t][3]); *(LAS u32x2*)(STs + ((et0 + t) * 16 + l15) * RP + db * 16 + 4 * q4) = w; }
    }
    const int tok_seg = b * SEQ + seg * 1024;
    const int lrow = tid >> 3, lcp = tid & 7;
    const bf16* kptr = Kb + (size_t)(tok_seg + lrow) * 512 + h * 64 + lcp * 8;
    const bf16* qptr = Q + (size_t)(tok_seg + lrow) * 512 + h * 64 + lcp * 8;
    const bf16* vptr = V + (size_t)(tok_seg + (tid >> 4)) * 1024 + h * 128 + (tid & 15) * 8;
    const float kd = exp2f(lg2 * (float)(63 - lrow));
    const float qd = exp2f(lg2 * (float)(ib * 16 + l15 + 1));
    constexpr int PF = FULL ? 2 : 4;
    const bf16* gptr = SGR + (size_t)(tok_seg + ib * 16 + l15) * 1024 + h * 128 + et0 * 16 + 4 * q4;
    u32x4 kwS[PF], qwS[PF], vw0S[PF], vw1S[PF];
#pragma unroll
    for (int u = 0; u < PF; ++u) { const size_t o5 = (size_t)u * 64 * 512, o10 = (size_t)u * 64 * 1024;
        kwS[u] = *(const u32x4*)(kptr + o5); vw0S[u] = *(const u32x4*)(vptr + o10); vw1S[u] = *(const u32x4*)(vptr + o10 + 32 * 1024);
        if (FULL) qwS[u] = *(const u32x4*)(qptr + o5); }
    const int trV = (8 * q4 + tq) * RPV + 4 * tp, trK = (8 * q4 + tq) * RP + 4 * tp;
    for (int c0 = 0; c0 < 16; c0 += PF) {
#pragma unroll
      for (int u = 0; u < PF; ++u) {
        const int ch = c0 + u;
        const int tok0 = tok_seg + ch * 64;
        u32x2 gw[4];
        if (FULL) {
#pragma unroll
            for (int t = 0; t < 4; ++t) gw[t] = *(const u32x2*)(gptr + (size_t)ch * 64 * 1024 + t * 16); }
        {
            const u32x4 kw = kwS[u];
            if (FULL) { *(LAS u32x4*)(Ks + lrow * RP + lcp * 8) = kw; *(LAS u32x4*)(Qs + lrow * RP + lcp * 8) = qwS[u]; }
            f32x4 k0, k1; unpack8(kw, k0, k1); *(LAS u32x4*)(KPs + lrow * RP + lcp * 8) = pack8(k0 * kd, k1 * kd);
            *(LAS u32x4*)(Vs + (tid >> 4) * RPV + (tid & 15) * 8) = vw0S[u]; *(LAS u32x4*)(Vs + ((tid >> 4) + 32) * RPV + (tid & 15) * 8) = vw1S[u];
            if (ch + PF < 16) { const size_t o5 = (size_t)(ch + PF) * 64 * 512, o10 = (size_t)(ch + PF) * 64 * 1024;
                kwS[u] = *(const u32x4*)(kptr + o5); vw0S[u] = *(const u32x4*)(vptr + o10); vw1S[u] = *(const u32x4*)(vptr + o10 + 32 * 1024);
                if (FULL) qwS[u] = *(const u32x4*)(qptr + o5); }
        }
        __syncthreads();
        if (FULL) {
#pragma unroll
            for (int jj = 0; jj < 2; ++jj) { const int jb = hf * 2 + jj; f32x4 sacc = (f32x4){0.f, 0.f, 0.f, 0.f};
#pragma unroll
                for (int ks = 0; ks < 2; ++ks) { const bf16x8 af = *(const LAS bf16x8*)(Ks + (jb * 16 + l15) * RP + ks * 32 + 8 * q4); const bf16x8 bfr = *(const LAS bf16x8*)(Qs + (ib * 16 + l15) * RP + ks * 32 + 8 * q4);
                    sacc = __builtin_amdgcn_mfma_f32_16x16x32_bf16(af, bfr, sacc, 0, 0, 0); }
                const int i = ib * 16 + l15, j0 = jb * 16 + 4 * q4; float pv[4];
#pragma unroll
                for (int r = 0; r < 4; ++r) { const int dist = i - (j0 + r); pv[r] = sacc[r] * exp2f(lg2 * (float)(dist < 0 ? -dist : dist)); }
                u32x2 w; w.x = pk2(pv[0], pv[1]); w.y = pk2(pv[2], pv[3]); *(LAS u32x2*)(Ps + i * RP + j0) = w; }
        }
        bf16x8 vf[2][4];
#pragma unroll
        for (int ks = 0; ks < 2; ++ks)
#pragma unroll
            for (int t = 0; t < 4; ++t) vf[ks][t] = tr_frag8(Vs + ks * 32 * RPV + (et0 + t) * 16 + trV, RPV);
#pragma unroll
        for (int t = 0; t < 4; ++t) Sacc[t] = Sacc[t] * d64;
#pragma unroll
        for (int ks = 0; ks < 2; ++ks) { const bf16x8 kf = tr_frag8(KPs + ks * 32 * RP + db * 16 + trK, RP);
#pragma unroll
            for (int t = 0; t < 4; ++t) Sacc[t] = __builtin_amdgcn_mfma_f32_16x16x32_bf16(kf, vf[ks][t], Sacc[t], 0, 0, 0); }
        if (FULL) {
            __syncthreads();
            f32x4 oacc[4], cacc[4];
#pragma unroll
            for (int t = 0; t < 4; ++t) { oacc[t] = (f32x4){0.f, 0.f, 0.f, 0.f}; cacc[t] = (f32x4){0.f, 0.f, 0.f, 0.f}; }
#pragma unroll
            for (int ks = 0; ks < 2; ++ks) { const bf16x8 pb = *(const LAS bf16x8*)(Ps + (ib * 16 + l15) * RP + ks * 32 + 8 * q4); const bf16x8 qb = *(const LAS bf16x8*)(Qs + (ib * 16 + l15) * RP + ks * 32 + 8 * q4);
#pragma unroll
                for (int t = 0; t < 4; ++t) { const bf16x8 sa = *(const LAS bf16x8*)(STs + ((et0 + t) * 16 + l15) * RP + ks * 32 + 8 * q4);
                    oacc[t] = __builtin_amdgcn_mfma_f32_16x16x32_bf16(vf[ks][t], pb, oacc[t], 0, 0, 0); cacc[t] = __builtin_amdgcn_mfma_f32_16x16x32_bf16(sa, qb, cacc[t], 0, 0, 0); } }
            float s = 0.f, sq = 0.f;
#pragma unroll
            for (int t = 0; t < 4; ++t)
#pragma unroll
                for (int r = 0; r < 4; ++r) { const float o = oacc[t][r] + qd * cacc[t][r]; oacc[t][r] = o; s += o; sq += o * o; }
            s += __shfl_xor(s, 16); sq += __shfl_xor(sq, 16); s += __shfl_xor(s, 32); sq += __shfl_xor(sq, 32);
            const int i = ib * 16 + l15;
            if (q4 == 0) { *(LAS f32x2*)(stat + (i * 2 + hf) * 2) = (f32x2){s, sq}; }
            __syncthreads();
#pragma unroll
            for (int t = 0; t < 4; ++t) { u32x2 w; w.x = pk2(Sacc[t][0], Sacc[t][1]); w.y = pk2(Sacc[t][2], Sacc[t][3]); *(LAS u32x2*)(STs + ((et0 + t) * 16 + l15) * RP + db * 16 + 4 * q4) = w; }
            const f32x4 st = *(const LAS f32x4*)(stat + i * 4);
            const float mean = (st[0] + st[2]) * (1.f / 128.f); const float var = (st[1] + st[3]) * (1.f / 128.f) - mean * mean; const float rstd = rsqrtf(fmaxf(var, 0.f) + EPS);
            bf16* orow = Ymix + (size_t)(tok0 + i) * 2048 + 1024 + h * 128 + et0 * 16 + 4 * q4;
#pragma unroll
            for (int t = 0; t < 4; ++t) { const float g0 = bf2f(gw[t].x & 0xffffu), g1 = bf2f(gw[t].x >> 16), g2 = bf2f(gw[t].y & 0xffffu), g3 = bf2f(gw[t].y >> 16);
                u32x2 w; w.x = pk2((oacc[t][0] - mean) * rstd * g0, (oacc[t][1] - mean) * rstd * g1); w.y = pk2((oacc[t][2] - mean) * rstd * g2, (oacc[t][3] - mean) * rstd * g3);
                *(u32x2*)(orow + t * 16) = w; }
        }
        __syncthreads();
      }
    }
    if (!FULL) { float* kv = KVseg + (size_t)item * 8192;
#pragma unroll
        for (int t = 0; t < 4; ++t)
#pragma unroll
            for (int r = 0; r < 4; ++r) kv[(db * 16 + 4 * q4 + r) * 128 + (et0 + t) * 16 + l15] = Sacc[t][r]; }
}

__device__ __forceinline__ void conv_item(int item, LAS unsigned char* lds, const bf16* U2, const bf16* SG2, const float* cw, const float* cb, const float* lng, const float* lnb, bf16* V2, int tid) {
    const int b = item >> 7, l0 = (item & 127) * 32, c0 = 2 * tid;
    LAS float* T = (LAS float*)lds;
    {
        f32x2 w[31];
        const char* cwb = (const char*)cw; const unsigned coff = (unsigned)c0 * 4u;
#pragma unroll
        for (int k = 0; k < 31; ++k) w[k] = *(const f32x2*)(cwb + (coff + (unsigned)k * 4096u));
        const f32x2 bias = *(const f32x2*)(cb + c0);
        const char* ub = (const char*)U2;
#pragma unroll 1
        for (int hf = 0; hf < 2; ++hf) {
            f32x2 u[46]; const int lb = l0 - 30 + hf * 16;
#pragma unroll
            for (int j = 0; j < 46; ++j) { const int l = lb + j; unsigned uw = 0u;
                if (l >= 0) uw = *(const unsigned*)(ub + ((unsigned)(b * SEQ + l) * 2048u + (unsigned)c0 * 2u));
                u[j][0] = bf2f(uw & 0xffffu); u[j][1] = bf2f(uw >> 16); }
#pragma unroll
            for (int t = 0; t < 16; ++t) { f32x2 a = bias;
#pragma unroll
                for (int k = 0; k < 31; ++k) a += w[k] * u[t + k];
                *(LAS f32x2*)(T + (hf * 16 + t) * 1024 + c0) = a; }
        }
    }
    __syncthreads();
    const int wid = tid >> 6, lane = tid & 63;
#pragma unroll
    for (int tt = 0; tt < 4; ++tt) { const int t = wid * 4 + tt; const size_t tok = (size_t)(b * SEQ + l0 + t);
        f32x4 v[4]; float s = 0.f;
#pragma unroll
        for (int q = 0; q < 4; ++q) { v[q] = *(const LAS f32x4*)(T + t * 1024 + lane * 4 + 256 * q); s += (v[q][0] + v[q][1]) + (v[q][2] + v[q][3]); }
        const float mean = wave_sum(s) * (1.f / 1024.f); float s2 = 0.f;
#pragma unroll
        for (int q = 0; q < 4; ++q) { v[q] = v[q] - mean; s2 += (v[q][0] * v[q][0] + v[q][1] * v[q][1]) + (v[q][2] * v[q][2] + v[q][3] * v[q][3]); }
        const float rstd = rsqrtf(wave_sum(s2) * (1.f / 1024.f) + EPS);
#pragma unroll
        for (int q = 0; q < 4; ++q) { const int c = lane * 4 + 256 * q; const f32x4 gg = *(const f32x4*)(lng + c), bb = *(const f32x4*)(lnb + c);
            const u32x2 gw = *(const u32x2*)(SG2 + tok * 1024 + c); float o[4];
            const float gt[4] = {bf2f(gw.x & 0xffffu), bf2f(gw.x >> 16), bf2f(gw.y & 0xffffu), bf2f(gw.y >> 16)};
#pragma unroll
            for (int i = 0; i < 4; ++i) o[i] = fsilu(v[q][i] * rstd * gg[i] + bb[i]) * gt[i];
            u32x2 w; w.x = pk2(o[0], o[1]); w.y = pk2(o[2], o[3]); *(u32x2*)(V2 + tok * 1024 + c) = w; } }
    __syncthreads();
}

typedef GAS unsigned gu32;
#define RLX_AGENT __ATOMIC_RELAXED, __HIP_MEMORY_SCOPE_AGENT
#define XB_TMO      128
#define XB_XCNT(j)  (256  + 64 * (j))
#define XB_XSUB(j)  (1280 + 64 * (j))
#define XB_XGEN(j)  (2304 + 64 * (j))
#define XB_TOP      3328
#define XB_TOPGEN   3392
#define XCD_BAR_WORDS 3456
#define XB_SPIN_CAP (1u << 18)

__device__ __forceinline__ unsigned xb_ld(unsigned* p)              { return __hip_atomic_load(p, __ATOMIC_RELAXED, __HIP_MEMORY_SCOPE_AGENT); }
__device__ __forceinline__ unsigned xb_add(unsigned* p, unsigned v) { return __hip_atomic_fetch_add(p, v, __ATOMIC_RELAXED, __HIP_MEMORY_SCOPE_AGENT); }
__device__ __forceinline__ unsigned xb_xcc_id() { return (unsigned)__builtin_amdgcn_s_getreg((3 << 11) | 20) & 0xFu; }
#define XB_SPIN(cond, bar) do { unsigned _sp = 0; while (cond) { __builtin_amdgcn_s_sleep(1); \
    if ((++_sp & 255u) == 0u) { if (xb_ld(&(bar)[XB_TMO])) break; if (_sp > XB_SPIN_CAP) { atomicAdd(&(bar)[XB_TMO], 1u); break; } } } } while (0)

struct XcdBarrier {
    unsigned* bar; unsigned x;
    volatile LAS unsigned* st;
};

__device__ __forceinline__ XcdBarrier xcd_barrier_post(unsigned* bar, volatile LAS unsigned* st) {
    XcdBarrier b; b.bar = bar; b.x = xb_xcc_id(); b.st = st;
    if (threadIdx.x == 0) (void)xb_add(&bar[XB_XCNT(b.x)], 1u);
    return b;
}
__device__ __forceinline__ void xcd_barrier_complete(unsigned* bar, unsigned x, unsigned& nloc, unsigned& nx) {
    const unsigned G = gridDim.x * gridDim.y * gridDim.z;
    unsigned sum, cnt, mine, sp = 0u;
    for (;;) {
        sum = 0u; cnt = 0u; mine = 0u;
#pragma unroll
        for (unsigned j = 0; j < 16; ++j) { const unsigned c = xb_ld(&bar[XB_XCNT(j)]); sum += c; cnt += (c > 0u) ? 1u : 0u; mine = (j == x) ? c : mine; }
        if (sum == G) break;
        __builtin_amdgcn_s_sleep(1);
        if ((++sp & 255u) == 0u) { if (xb_ld(&bar[XB_TMO])) break; if (sp > XB_SPIN_CAP) { atomicAdd(&bar[XB_TMO], 1u); break; } }
    }
    nloc = mine > 0u ? mine : 1u; nx = cnt > 0u ? cnt : 1u;
}

__device__ __forceinline__ void xcd_barrier(const XcdBarrier& b) {
    asm volatile("s_waitcnt vmcnt(0)" ::: "memory");
    __syncthreads();
    if (threadIdx.x == 0) {
        unsigned* bar = b.bar;
        __builtin_amdgcn_s_waitcnt(0);
        unsigned nloc = b.st[0], nx = b.st[1];
        if (nloc == 0u) { xcd_barrier_complete(bar, b.x, nloc, nx); b.st[0] = nloc; b.st[1] = nx; }
        const unsigned old = xb_add(&bar[XB_XSUB(b.x)], 1u);
        const unsigned gen = old / nloc;
        if (old + 1u == (gen + 1u) * nloc) {
            __builtin_amdgcn_fence(__ATOMIC_RELEASE, "agent");
            asm volatile("s_waitcnt vmcnt(0)" ::: "memory");
            const unsigned og = xb_add(&bar[XB_TOP], 1u);
            const unsigned tg = og / nx;
            if (og + 1u == (tg + 1u) * nx) xb_add(&bar[XB_TOPGEN], 1u);
            else XB_SPIN(xb_ld(&bar[XB_TOPGEN]) == tg, bar);
            __builtin_amdgcn_fence(__ATOMIC_ACQUIRE, "agent");
            xb_add(&bar[XB_XGEN(b.x)], 1u);
            asm volatile("s_waitcnt vmcnt(0)" ::: "memory");
        } else {
            XB_SPIN(xb_ld(&bar[XB_XGEN(b.x)]) == gen, bar);
            __builtin_amdgcn_fence(__ATOMIC_ACQUIRE, "agent");
            asm volatile("s_waitcnt vmcnt(0)" ::: "memory");
        }
    }
    __syncthreads();
}


#ifndef MK_PER_PHASE
#define MK_PER_PHASE 0
#endif
#ifndef PROBE_RET1_REPS
#define PROBE_RET1_REPS 1
#endif
#ifndef PROBE_RET3_REPS
#define PROBE_RET3_REPS 1
#endif
#ifndef PROBE_DUP_MASK
#define PROBE_DUP_MASK 0
#endif
constexpr int N_PHASES = 11;
struct Args { const float* in[21]; float* out; unsigned char* ws; int ph_lo, ph_hi; };

__global__ void __launch_bounds__(NTHR, 2) fwd_megakernel(Args args) {
    extern __shared__ __attribute__((aligned(16))) unsigned char lds_raw[];
    LAS unsigned char* lds = (LAS unsigned char*)lds_raw;
    const int tid = threadIdx.x, lane = tid & 63, wave = __builtin_amdgcn_readfirstlane(tid >> 6);
    const int G = gridDim.x, bid = blockIdx.x;
    const int gw = bid * NWAVES + wave, NGW = G * NWAVES;
    unsigned char* ws = args.ws;
    const float* x = args.in[0]; const float* norm_g = args.in[1]; const float* final_g = args.in[2]; const float* w_in_ab = args.in[3];
    const float* s5_a_re = args.in[4]; const float* s5_a_im = args.in[5]; const float* s5_log_dt = args.in[6]; const float* s5_b_re = args.in[7]; const float* s5_b_im = args.in[8];
    const float* s5_c_re = args.in[9]; const float* s5_c_im = args.in[10]; const float* s5_d = args.in[11]; const float* s5_glu_w = args.in[12]; const float* s5_glu_b = args.in[13];
    const float* w_out_ab = args.in[14]; const float* w_in_c = args.in[15]; const float* conv_w = args.in[16]; const float* conv_b = args.in[17];
    const float* conv_ln_g = args.in[18]; const float* conv_ln_b = args.in[19]; const float* w_out_c = args.in[20];
    float* out = args.out;
    float* ss1 = (float*)(ws + WS_CTL);
    float* ropec = (float*)(ws + WS_ROPE); float* ropes = ropec + 4096 * 32;
    bf16* WinT = (bf16*)(ws + WS_WIN); bf16* WgluT = (bf16*)(ws + WS_WGLU); bf16* WoutT = (bf16*)(ws + WS_WOUT); bf16* WincT = (bf16*)(ws + WS_WINC); bf16* WoutcT = (bf16*)(ws + WS_WOUTC);
    bf16* Tg = (bf16*)(ws + WS_TG); bf16* Wg = (bf16*)(ws + WS_WG); float* L16 = (float*)(ws + WS_L16); float* KVseg = (float*)(ws + WS_KVSEG);
    bf16* XN = (bf16*)(ws + WS_XN); float* Sloc = (float*)(ws + WS_XN); bf16* Yg = (bf16*)(ws + WS_XN); bf16* XG2 = (bf16*)(ws + WS_XN);
    bf16* Aext = (bf16*)(ws + WS_AEXT); bf16* SG5 = (bf16*)(ws + WS_SG5); bf16* Qb = (bf16*)(ws + WS_Q); bf16* Kb = (bf16*)(ws + WS_K); bf16* Vb = (bf16*)(ws + WS_V); bf16* SGR = (bf16*)(ws + WS_SGR);
    float* X1 = (float*)(ws + WS_X1); bf16* U2 = (bf16*)(ws + WS_U2); bf16* SG2 = (bf16*)(ws + WS_SG2); bf16* V2 = (bf16*)(ws + WS_V2);
    bf16* Ymix = (bf16*)out;

    const int lo = args.ph_lo, hi = args.ph_hi;
#define IN(k) (lo <= (k) && (k) < hi)
#define SEAM(k) do { if (IN(k) && IN((k) + 1)) { if ((k) == 0) cg::this_grid().sync(); else xcd_barrier(xbar); } } while (0)
    if (tid < 4) ((volatile LAS unsigned*)(lds + 131072))[tid] = 0u;
    __syncthreads();
    XcdBarrier xbar; xbar.bar = (unsigned*)(ws + WS_CTL + 524288); xbar.x = 0; xbar.st = (volatile LAS unsigned*)(lds + 131072);
    if (hi - lo > 1) xbar = xcd_barrier_post((unsigned*)(ws + WS_CTL + 524288), (volatile LAS unsigned*)(lds + 131072));

    if (IN(0)) {
        LAS float* scr = (LAS float*)(lds + wave * 16384);
        constexpr int I_IN = 16 * 160, I_GLU = 16 * 32, I_OUT = 32 * 32, I_INC = 16 * 96, I_OUTC = 16 * 32;
        constexpr int NITEMS = I_IN + I_GLU + I_OUT + I_INC + I_OUTC;
        for (int it = gw; it < NITEMS; it += NGW) {
            int r = it;
            if (r < I_IN) { p0_transpose_item(w_in_ab, 1024, 5120, WinT, 1, scr, r, lane); continue; } r -= I_IN;
            if (r < I_GLU) { p0_transpose_item(s5_glu_w, 1024, 1024, WgluT, 0, scr, r, lane); continue; } r -= I_GLU;
            if (r < I_OUT) { p0_transpose_item(w_out_ab, 2048, 1024, WoutT, 0, scr, r, lane); continue; } r -= I_OUT;
            if (r < I_INC) { p0_transpose_item(w_in_c, 1024, 3072, WincT, 2, scr, r, lane); continue; } r -= I_INC;
            p0_transpose_item(w_out_c, 1024, 1024, WoutcT, 0, scr, r, lane);
        }
        for (int e = bid * NTHR + tid; e < 4096 * 32; e += G * NTHR) { const int pos = e >> 5, f = e & 31;
            const double freq = exp(-(double)f * (9.210340371976182736 / 32.0)); const double ang = (double)pos * freq; const double tw = 6.283185307179586476925286766559;
            const float red = (float)(ang - tw * __builtin_rint(ang / tw)); ropec[e] = cosf(red); ropes[e] = sinf(red); }
        __syncthreads();
        for (int it = bid; it < 1024; it += G) s5_tables_item(it, (LAS float*)lds, s5_a_re, s5_a_im, s5_log_dt, s5_b_re, s5_b_im, s5_c_re, s5_c_im, s5_d, Tg, Wg, L16, tid);
        for (int m = gw; m < M; m += NGW) rms_row_to_bf16(x + (size_t)m * DM, norm_g, XN + (size_t)m * DM, lane);
    }
    SEAM(0);
    if (IN(1)) {
        pg8::Gemm g{XN, WinT, 1024, 1024, 1024, 0, 0}; pg8::StaticOrder S; S.init(M, 5120, G, bid);
        EpiWin E{Aext, SG5, Qb, Kb, Vb, SGR, ropec, ropes};
        pg8::gemm_phase<EpiWin, pg8::StaticOrder, true, false>(lds, g, S, E);
    }
    SEAM(1);
    if (IN(2)) {
        pg8::Gemm g{Aext, Wg, 256, AEXT_LD, 256, 0, 0}; pg8::GroupOrder S{G, bid};
        EpiSloc E{Sloc};
        pg8::gemm_phase<EpiSloc, pg8::GroupOrder, true, true>(lds, g, S, E);
        for (int rep = 0; rep < PROBE_RET1_REPS; ++rep) for (int it = bid; it < 256; it += G) { if ((it & 3) != 3) retention_item<false>(it, lds, Qb, Kb, Vb, SGR, KVseg, Ymix, tid); }
    }
    SEAM(2);
    if (IN(3)) { for (int it = bid; it < 512; it += G) s5_scan_item(it, (LAS float*)lds, Sloc, L16, Aext, tid); }
    SEAM(3);
    if (IN(4)) {
        pg8::Gemm g{Aext, Tg, AEXT_LD, AEXT_LD, AEXT_LD, 0, 0}; pg8::GroupOrder S{G, bid};
        EpiYg E{Yg};
        pg8::gemm_phase<EpiYg, pg8::GroupOrder, true, false>(lds, g, S, E);
        for (int rep = 0; rep < PROBE_RET3_REPS; ++rep) for (int it = bid; it < 256; it += G) retention_item<true>(it, lds, Qb, Kb, Vb, SGR, KVseg, Ymix, tid);
    }
    SEAM(4);
    if (IN(5)) {
        pg8::Gemm g{Yg, WgluT, 1024, 0, 1024, 1, M}; pg8::StaticOrder S; S.init(M, 1024, G, bid);
        EpiGlu E{Yg, SG5, s5_glu_b, Ymix};
        pg8::gemm_phase<EpiGlu, pg8::StaticOrder, true, false>(lds, g, S, E);
    }
    SEAM(5);
    if (IN(6)) {
        pg8::Gemm g{Ymix, WoutT, 2048, 2048, 2048, 0, 0}; pg8::StaticOrder S; S.init(M, 1024, G, bid);
        EpiWout E{x, X1, XG2, norm_g + 1024, ss1};
        pg8::gemm_phase<EpiWout, pg8::StaticOrder, true, false>(lds, g, S, E);
    }
    SEAM(6);
    if (IN(7)) {
        pg8::Gemm g{XG2, WincT, 1024, 1024, 1024, 0, 0}; pg8::StaticOrder S; S.init(M, 3072, G, bid);
        EpiWinC E{ss1, U2, SG2};
        pg8::gemm_phase<EpiWinC, pg8::StaticOrder, true, false>(lds, g, S, E);
    }
    SEAM(7);
    if (IN(8)) { for (int it = bid; it < 1024; it += G) conv_item(it, lds, U2, SG2, conv_w, conv_b, conv_ln_g, conv_ln_b, V2, tid); }
    SEAM(8);
    if (IN(9)) {
        pg8::Gemm g{V2, WoutcT, 1024, 1024, 1024, 0, 0}; pg8::StaticOrder S; S.init(M, 1024, G, bid);
        EpiWoutC E{X1, out};
        pg8::gemm_phase<EpiWoutC, pg8::StaticOrder, true, false>(lds, g, S, E);
    }
    SEAM(9);
    if (IN(10)) { for (int m = gw; m < M; m += NGW) rms_row_f32(out + (size_t)m * DM, final_g, lane); }
#undef IN
#undef SEAM
}

extern "C" void kernel_launch(void* const* d_in, const int* in_sizes, int n_in, void* d_out, int out_size, void* d_ws, size_t ws_size, hipStream_t stream) {
    static int grid = 0;
    if (grid == 0) {
        if (n_in != 21 || out_size != M * DM || ws_size < WS_END) { fprintf(stderr, "kernel_launch: unexpected shapes (n_in %d, out %d, ws %zu)\n", n_in, out_size, ws_size); grid = -1; return; }
        int dev = 0, cus = 0, per_cu = 0;
        if (hipGetDevice(&dev) != hipSuccess || hipDeviceGetAttribute(&cus, hipDeviceAttributeMultiprocessorCount, dev) != hipSuccess) { grid = -1; return; }
        if (hipFuncSetAttribute((const void*)fwd_megakernel, hipFuncAttributeMaxDynamicSharedMemorySize, LDS_BYTES) != hipSuccess) { fprintf(stderr, "kernel_launch: hipFuncSetAttribute failed\n"); grid = -1; return; }
        if (hipOccupancyMaxActiveBlocksPerMultiprocessor(&per_cu, (const void*)fwd_megakernel, NTHR, LDS_BYTES) != hipSuccess || per_cu < 1) { fprintf(stderr, "kernel_launch: occupancy query says %d\n", per_cu); per_cu = 1; }
        (void)hipGetLastError();
        grid = cus;
    }
    if (grid < 0) return;
    (void)hipMemsetAsync((char*)d_ws + WS_CTL, 0, CTL_ZERO_BYTES, stream);
    Args a{};
    for (int i = 0; i < 21; ++i) a.in[i] = (const float*)d_in[i];
    a.out = (float*)d_out; a.ws = (unsigned char*)d_ws;
#if MK_PER_PHASE
    for (int p = 0; p < N_PHASES; ++p) { a.ph_lo = p; a.ph_hi = p + 1; const int reps = ((PROBE_DUP_MASK >> p) & 1) ? 2 : 1;
        for (int r = 0; r < reps; ++r) hipLaunchKernelGGL(fwd_megakernel, dim3(grid), dim3(NTHR), LDS_BYTES, stream, a); }
#else
    a.ph_lo = 0; a.ph_hi = N_PHASES;
    void* kargs[] = {&a};
    hipError_t e = hipLaunchCooperativeKernel((const void*)fwd_megakernel, dim3(grid), dim3(NTHR), kargs, LDS_BYTES, stream);
    if (e != hipSuccess) fprintf(stderr, "kernel_launch: cooperative launch failed: %s (grid %d)\n", hipGetErrorString(e), grid);
#endif
}
```

```cpp
#include <hip/hip_runtime.h>
#include <hip/hip_cooperative_groups.h>
#include <cstdio>
#include <cstdint>
namespace cg = cooperative_groups;

namespace pg8 {
#define PG8_LAS __attribute__((address_space(3)))
typedef unsigned short bf16_t;
typedef short bf16x8 __attribute__((ext_vector_type(8)));
typedef float f32x4 __attribute__((ext_vector_type(4)));
typedef float f32x2 __attribute__((ext_vector_type(2)));
typedef unsigned u32x4 __attribute__((ext_vector_type(4)));
typedef unsigned u32x2 __attribute__((ext_vector_type(2)));
constexpr int BM = 256, BK = 64, HALF = 128, HTB = HALF * BK * 2  , STAGE_BYTES = 8 * HTB, NXCD = 8, WGM = 8;

__host__ __device__ __forceinline__ int lds_byte(int r, int c) { const int st = (r >> 4) * 2 + (c >> 5), rr = r & 15, cc = c & 31, ob = rr * 64 + cc * 2; return st * 1024 + (ob ^ (((ob >> 9) & 1) << 5)); }
__host__ __device__ __forceinline__ void stage_rc(int b, int& R, int& C) { const int st = b / 1024, sb = b % 1024, swz = sb ^ (((sb >> 9) & 1) << 5); R = (st >> 1) * 16 + swz / 64; C = (st & 1) * 32 + (swz % 64) / 2; }
__host__ __device__ __forceinline__ int perm32(int rho) { const int n = rho >> 4, i = rho & 15; return 8 * (i >> 2) + 4 * n + (i & 3); }

struct Unit { int pm, pn; };
struct Gemm { const bf16_t* A; const bf16_t* Bt; int K, lda, ldb, amode, gM; };

struct StaticOrder {
    int nM, nN, nwg, G, c;
    __host__ __device__ void init(int M, int N, int G_, int c_) { nM = M / BM; nN = N / BM; nwg = nM * nN; G = G_; c = c_; }
    __host__ __device__ bool next(int i, Unit& u) const {
        const long L = (long)i * G + c; if (L >= nwg) return false;
        int wgid = (int)L; { const int q = nwg / NXCD, r = nwg % NXCD, xcd = wgid % NXCD, off = wgid / NXCD; wgid = (xcd < r ? xcd * (q + 1) : r * (q + 1) + (xcd - r) * q) + off; }
        const int nig = WGM * nN, gid = wgid / nig, fm = gid * WGM, gsz = (nM - fm) < WGM ? (nM - fm) : WGM;
        u.pm = fm + ((wgid % nig) % gsz); u.pn = (wgid % nig) / gsz; return true;
    }
};
struct GroupOrder {
    int G, c;
    __host__ __device__ bool next(int i, Unit& u) const { const int L = i * G + c; if (L >= 512) return false; u.pm = L; u.pn = L >> 3; return true; }
};

__device__ __forceinline__ unsigned cvt_pk_bf16(float lo, float hi) { unsigned r; asm volatile("v_cvt_pk_bf16_f32 %0, %1, %2" : "=v"(r) : "v"(lo), "v"(hi)); return r; }

template <class Epi, class Sched, bool ALIGN_EPI, bool SKIPB1, bool ZSKIP = false>
__device__ __forceinline__ void gemm_phase(PG8_LAS unsigned char* lds, const Gemm g, const Sched& S, const Epi& E) {
    const int tid = threadIdx.x, wid = __builtin_amdgcn_readfirstlane(tid >> 6), lane = tid & 63, wr = wid >> 2, wc = wid & 3, fr = lane & 15, fq = lane >> 4;
    const int K = g.K, nt = K / BK;
    unsigned voffA[2], voffB[2];
#pragma unroll
    for (int i = 0; i < 2; ++i) { int R, C; stage_rc(tid * 16 + i * 8192, R, C); const int Rb = Epi::PERM ? ((R & ~31) + perm32(R & 31)) : R;
        voffA[i] = g.amode ? (unsigned)(((C >> 4) * g.gM + R) * 16 + (C & 15)) * 2u : (unsigned)(R * g.lda + C) * 2u;
        voffB[i] = (unsigned)(Rb * g.ldb + C) * 2u; }
    const size_t kstepA = g.amode ? (size_t)g.gM * 128 : (size_t)(BK * 2);
    const size_t kstepB = (size_t)(BK * 2);
    const size_t hstepA = g.amode ? (size_t)HALF * 32 : (size_t)HALF * g.lda * 2;
    const size_t hstepB = (size_t)HALF * g.ldb * 2;
    const size_t tstepA = 2 * hstepA, tstepB = 2 * hstepB;
    const unsigned ldsw = (unsigned)wid * 1024u;
    const int aoff = lds_byte(wr * 64 + fr, fq * 8), boff = lds_byte(wc * 32 + fr, fq * 8);
#define PG8_SA(b, h) (((b) * 2 + (h)) * HTB)
#define PG8_SB(b, h) ((4 + (b) * 2 + (h)) * HTB)
#define PG8_STAGE(bufoff, gbase, voff) do { _Pragma("unroll") for (int _i = 0; _i < 2; ++_i) \
        __builtin_amdgcn_global_load_lds((const unsigned*)((const char*)(gbase) + (voff)[_i]), (PG8_LAS unsigned*)(lds + (bufoff) + ldsw + _i * 8192), 16, 0, 0); } while (0)
#define PG8_LDA(dst, b, h) do { _Pragma("unroll") for (int m = 0; m < 4; ++m) _Pragma("unroll") for (int k = 0; k < 2; ++k) dst[m][k] = *(const PG8_LAS bf16x8*)(lds + PG8_SA(b, h) + aoff + m * 2048 + k * 1024); } while (0)
#define PG8_LDB(dst, b, h) do { _Pragma("unroll") for (int n = 0; n < 2; ++n) _Pragma("unroll") for (int k = 0; k < 2; ++k) dst[n][k] = *(const PG8_LAS bf16x8*)(lds + PG8_SB(b, h) + boff + n * 2048 + k * 1024); } while (0)
#define PG8_MMA(ai, bj, At, Bt) do { __builtin_amdgcn_s_setprio(1); _Pragma("unroll") for (int m = 0; m < 4; ++m) _Pragma("unroll") for (int n = 0; n < 2; ++n) _Pragma("unroll") for (int k = 0; k < 2; ++k) \
        acc[ai][bj][m][n] = __builtin_amdgcn_mfma_f32_16x16x32_bf16(Bt[n][k], At[m][k], acc[ai][bj][m][n], 0, 0, 0); __builtin_amdgcn_s_setprio(0); } while (0)
#define PG8_MMA1(ai, At, Bt) do { if constexpr (!SKIPB1) PG8_MMA(ai, 1, At, Bt); } while (0)
#define PG8_MMA0(ai, At, Bt) do { if (!(ZSKIP && t == 2)) PG8_MMA(ai, 0, At, Bt); } while (0)
#define PG8_WAIT_V(n) asm volatile("s_waitcnt vmcnt(" #n ")" ::: "memory")
#define PG8_WAIT_L(n) asm volatile("s_waitcnt lgkmcnt(" #n ")" ::: "memory")
#define PG8_BAR __builtin_amdgcn_s_barrier()
#define PG8_SCHED __builtin_amdgcn_sched_barrier(0)
    Unit cur, nxt; int ui = 0;
    if (!S.next(0, cur)) return;
    f32x4 acc[2][2][4][2];
#pragma unroll
    for (int a = 0; a < 2; ++a)
#pragma unroll
        for (int b = 0; b < 2; ++b)
#pragma unroll
            for (int m = 0; m < 4; ++m)
#pragma unroll
                for (int n = 0; n < 2; ++n) acc[a][b][m][n] = (f32x4){0.f, 0.f, 0.f, 0.f};
    bf16x8 At[4][2], B0[2][2], B1[2][2];
    const char* cA = (const char*)g.A + (size_t)cur.pm * tstepA; const char* cB = (const char*)g.Bt + (size_t)cur.pn * tstepB;
    PG8_STAGE(PG8_SB(0, 0), cB, voffB); PG8_STAGE(PG8_SB(0, 1), cB + hstepB, voffB); PG8_STAGE(PG8_SA(0, 0), cA, voffA); PG8_STAGE(PG8_SA(0, 1), cA + hstepA, voffA);
    if (wr == 1) PG8_BAR;
    PG8_WAIT_V(2); PG8_BAR;
    PG8_STAGE(PG8_SB(1, 0), cB + kstepB, voffB); PG8_STAGE(PG8_SA(1, 0), cA + kstepA, voffA); PG8_STAGE(PG8_SB(1, 1), cB + hstepB + kstepB, voffB);
    PG8_WAIT_V(6); PG8_BAR;
    for (;;) {
        const bool has_next = S.next(ui + 1, nxt);
        const char* nA = has_next ? (const char*)g.A + (size_t)nxt.pm * tstepA : cA; const char* nB = has_next ? (const char*)g.Bt + (size_t)nxt.pn * tstepB : cB;
        for (int t = 0; t < nt; t += 2) {
            const bool last = (t == nt - 2);
            const char* a1 = cA + (size_t)(t + 1) * kstepA;
            const char* a2 = last ? nA : cA + (size_t)(t + 2) * kstepA; const char* b2 = last ? nB : cB + (size_t)(t + 2) * kstepB;
            const char* a3 = a2 + kstepA; const char* b3 = b2 + kstepB;
            PG8_LDB(B0, 0, 0); PG8_LDB(B1, 0, 1); PG8_SCHED; PG8_LDA(At, 0, 0); PG8_STAGE(PG8_SA(1, 1), a1 + hstepA, voffA);
            PG8_WAIT_V(8); PG8_WAIT_L(0); PG8_BAR; PG8_MMA0(0, At, B0); PG8_MMA1(0, At, B1); PG8_BAR; PG8_SCHED;
            PG8_LDA(At, 0, 1); PG8_STAGE(PG8_SB(0, 0), b2, voffB); PG8_STAGE(PG8_SB(0, 1), b2 + hstepB, voffB); PG8_STAGE(PG8_SA(0, 0), a2, voffA);
            PG8_WAIT_V(8); PG8_WAIT_L(0); PG8_BAR; PG8_MMA0(1, At, B0); PG8_MMA1(1, At, B1); PG8_BAR; PG8_SCHED;
            PG8_LDB(B0, 1, 0); PG8_LDB(B1, 1, 1); PG8_SCHED; PG8_LDA(At, 1, 0); PG8_STAGE(PG8_SA(0, 1), a2 + hstepA, voffA);
            PG8_WAIT_V(8); PG8_WAIT_L(0); PG8_BAR; PG8_MMA0(0, At, B0); PG8_MMA1(0, At, B1); PG8_BAR; PG8_SCHED;
            PG8_LDA(At, 1, 1); PG8_STAGE(PG8_SB(1, 0), b3, voffB); PG8_STAGE(PG8_SB(1, 1), b3 + hstepB, voffB); PG8_STAGE(PG8_SA(1, 0), a3, voffA);
            PG8_WAIT_V(8); PG8_WAIT_L(0); PG8_BAR; PG8_MMA0(1, At, B0); PG8_MMA1(1, At, B1); PG8_BAR; PG8_SCHED;
        }
        if constexpr (ALIGN_EPI) { if (wr == 0) PG8_BAR; }
        E(acc, cur, wr, wc, fr, fq);
        if (!has_next) break;
#pragma unroll
        for (int a = 0; a < 2; ++a)
#pragma unroll
            for (int b = 0; b < 2; ++b)
#pragma unroll
                for (int m = 0; m < 4; ++m)
#pragma unroll
                    for (int n = 0; n < 2; ++n) acc[a][b][m][n] = (f32x4){0.f, 0.f, 0.f, 0.f};
        cur = nxt; cA = nA; cB = nB; ++ui;
        if constexpr (ALIGN_EPI) { if (wr == 1) PG8_BAR; }
    }
    PG8_WAIT_V(0);
    if constexpr (!ALIGN_EPI) { if (wr == 0) PG8_BAR; }
    PG8_BAR;
#undef PG8_SA
#undef PG8_SB
#undef PG8_STAGE
#undef PG8_LDA
#undef PG8_LDB
#undef PG8_MMA
#undef PG8_MMA1
#undef PG8_MMA0
#undef PG8_WAIT_V
#undef PG8_WAIT_L
#undef PG8_BAR
#undef PG8_SCHED
}
}

#define GAS __attribute__((address_space(1)))
#define LAS __attribute__((address_space(3)))
typedef unsigned short bf16;
typedef pg8::f32x4 f32x4;
typedef pg8::f32x2 f32x2;
typedef pg8::u32x4 u32x4;
typedef pg8::u32x2 u32x2;
typedef pg8::bf16x8 bf16x8;
constexpr int NWAVES = 8, NTHR = 512;
constexpr int M = 32768, DM = 1024, SEQ = 4096;
constexpr float EPS = 1e-6f;
constexpr size_t MiB = 1u << 20;
constexpr size_t WS_CTL = 0, CTL_ZERO_BYTES = 1 * MiB;
constexpr size_t WS_ROPE = 1 * MiB;
constexpr size_t WS_WIN = 2 * MiB, WS_WGLU = 12 * MiB, WS_WOUT = 14 * MiB, WS_WINC = 18 * MiB, WS_WOUTC = 24 * MiB;
constexpr size_t WS_TG = 26 * MiB, WS_WG = 38 * MiB, WS_L16 = 46 * MiB, WS_KVSEG = 48 * MiB;
constexpr size_t WS_XN = 64 * MiB;
constexpr size_t WS_AEXT = 128 * MiB;
constexpr size_t WS_SG5 = 224 * MiB, WS_Q = 288 * MiB, WS_K = 320 * MiB, WS_V = 352 * MiB, WS_SGR = 416 * MiB;
constexpr size_t WS_X1 = 128 * MiB, WS_U2 = 256 * MiB, WS_SG2 = 320 * MiB, WS_V2 = 384 * MiB, WS_END = 480 * MiB;
constexpr int LDS_BYTES = 155648;
constexpr int AEXT_LD = 384;

__device__ __forceinline__ float fsigmoid(float x) { return __builtin_amdgcn_rcpf(1.0f + __expf(-x)); }
__device__ __forceinline__ float fsilu(float x) { return x * fsigmoid(x); }
__device__ __forceinline__ float fsig2(float a, float b) { return __builtin_amdgcn_rcpf((1.0f + __expf(-a)) * (1.0f + __expf(-b))); }
__device__ __forceinline__ float fgelu_tanh(float x) { const float u = 1.5957691216f * (x + 0.044715f * x * x * x); return x * fsigmoid(u); }
__device__ __forceinline__ unsigned f2bf(float f) { unsigned u = __builtin_bit_cast(unsigned, f); return (u + 0x7fffu + ((u >> 16) & 1u)) >> 16; }
__device__ __forceinline__ float bf2f(unsigned h) { return __builtin_bit_cast(float, h << 16); }
__device__ __forceinline__ unsigned pk2(float lo, float hi) { return pg8::cvt_pk_bf16(lo, hi); }
__device__ __forceinline__ u32x4 pack8(f32x4 a, f32x4 b) { u32x4 w; w.x = pk2(a[0], a[1]); w.y = pk2(a[2], a[3]); w.z = pk2(b[0], b[1]); w.w = pk2(b[2], b[3]); return w; }
__device__ __forceinline__ void unpack8(u32x4 w, f32x4& a, f32x4& b) {
    a[0] = bf2f(w.x & 0xffffu); a[1] = bf2f(w.x >> 16); a[2] = bf2f(w.y & 0xffffu); a[3] = bf2f(w.y >> 16);
    b[0] = bf2f(w.z & 0xffffu); b[1] = bf2f(w.z >> 16); b[2] = bf2f(w.w & 0xffffu); b[3] = bf2f(w.w >> 16); }
__device__ __forceinline__ float wave_sum(float v) {
#pragma unroll
    for (int o = 1; o < 64; o <<= 1) v += __shfl_xor(v, o);
    return v;
}

typedef f32x4 AccT[2][2][4][2];

struct EpiWin {
    static constexpr bool PERM = true;
    bf16 *Aext, *SG5, *Q, *Kb, *V, *SGR; const float *ropec, *ropes;
    __device__ __forceinline__ void operator()(const AccT& acc, const pg8::Unit& u, int wr, int wc, int fr, int fq) const {
        const int pn = u.pn, row0 = u.pm * 256 + wr * 64 + fr;
        const bool rope = pn >= 8 && pn < 12; const int jr = 4 * (wc & 1) + fq;
#pragma unroll
        for (int ai = 0; ai < 2; ++ai) {
            f32x4 csv[4], snv[4];
            if (rope) {
#pragma unroll
                for (int m = 0; m < 4; ++m) { const int pos = (row0 + ai * 128 + m * 16) & (SEQ - 1); csv[m] = *(const f32x4*)(ropec + pos * 32 + 4 * jr); snv[m] = *(const f32x4*)(ropes + pos * 32 + 4 * jr); }
            }
#pragma unroll
            for (int m = 0; m < 4; ++m) { const int row = row0 + ai * 128 + m * 16;
#pragma unroll
                for (int bj = 0; bj < 2; ++bj) { const int colt = pn * 256 + bj * 128 + wc * 32 + 8 * fq;
                    f32x4 v0 = acc[ai][bj][m][0], v1 = acc[ai][bj][m][1];
                    if (pn < 4) {
                        const int g = colt >> 4, h0 = colt & 15;
                        bf16* dst = Aext + (size_t)g * (2048 * AEXT_LD) + (size_t)(row >> 4) * AEXT_LD + (row & 15) * 16 + h0;
                        *(u32x4*)dst = pack8(v0, v1);
                    } else if (pn < 8) {
                        *(u32x4*)(SG5 + (size_t)row * 1024 + (colt - 1024)) = pack8(v0, v1);
                    } else if (pn < 12) {
                        const bool isq = pn < 10; const int c = colt - (isq ? 2048 : 2560);
                        const f32x4 cs = csv[m], sn = snv[m];
                        const float sc = isq ? 0.125f : 1.0f;
                        f32x4 o1 = (v0 * cs - v1 * sn) * sc, o2 = (v0 * sn + v1 * cs) * sc;
                        *(u32x4*)((isq ? Q : Kb) + (size_t)row * 512 + c) = pack8(o1, o2);
                    } else if (pn < 16) {
                        *(u32x4*)(V + (size_t)row * 1024 + (colt - 3072)) = pack8(v0, v1);
                    } else {
                        *(u32x4*)(SGR + (size_t)row * 1024 + (colt - 4096)) = pack8(v0, v1);
                    } } } }
    }
};
struct EpiSloc {
    static constexpr bool PERM = false;
    float* O;
    __device__ __forceinline__ void operator()(const AccT& acc, const pg8::Unit& u, int wr, int wc, int fr, int fq) const {
        const int row0 = u.pm * 256 + wr * 64 + fr, col0 = wc * 32 + 4 * fq;
#pragma unroll
        for (int ai = 0; ai < 2; ++ai)
#pragma unroll
            for (int m = 0; m < 4; ++m) { float* rowp = O + (size_t)(row0 + ai * 128 + m * 16) * 128 + col0;
#pragma unroll
                for (int n = 0; n < 2; ++n) *(f32x4*)(rowp + 16 * n) = acc[ai][0][m][n]; }
    }
};
struct EpiYg {
    static constexpr bool PERM = true;
    bf16* O;
    __device__ __forceinline__ void operator()(const AccT& acc, const pg8::Unit& u, int wr, int wc, int fr, int fq) const {
        const int row0 = u.pm * 256 + wr * 64 + fr, col0 = wc * 32 + 8 * fq;
#pragma unroll
        for (int ai = 0; ai < 2; ++ai)
#pragma unroll
            for (int m = 0; m < 4; ++m) { bf16* rowp = O + (size_t)(row0 + ai * 128 + m * 16) * 256 + col0;
#pragma unroll
                for (int bj = 0; bj < 2; ++bj) { f32x4 v0 = acc[ai][bj][m][0], v1 = acc[ai][bj][m][1];
#pragma unroll
                    for (int i = 0; i < 4; ++i) { v0[i] = fgelu_tanh(v0[i]); v1[i] = fgelu_tanh(v1[i]); }
                    *(u32x4*)(rowp + bj * 128) = pack8(v0, v1); } }
    }
};
struct EpiNull {
    static constexpr bool PERM = true;
    __device__ __forceinline__ void operator()(const AccT& acc, const pg8::Unit&, int, int, int, int) const {
#pragma unroll
        for (int a = 0; a < 2; ++a)
#pragma unroll
            for (int b = 0; b < 2; ++b)
#pragma unroll
                for (int m = 0; m < 4; ++m)
#pragma unroll
                    for (int n = 0; n < 2; ++n) asm volatile("" :: "v"(acc[a][b][m][n]));
    }
};
struct EpiGlu {
    static constexpr bool PERM = true;
    const bf16* Yg; const bf16* SG5; const float* bias; bf16* Ymix;
    __device__ __forceinline__ void operator()(const AccT& acc, const pg8::Unit& u, int wr, int wc, int fr, int fq) const {
        const int row0 = u.pm * 256 + wr * 64 + fr, colb = u.pn * 256 + wc * 32 + 8 * fq;
        f32x4 bv[2][2];
#pragma unroll
        for (int bj = 0; bj < 2; ++bj)
#pragma unroll
            for (int n = 0; n < 2; ++n) bv[bj][n] = *(const f32x4*)(bias + colb + bj * 128 + 4 * n);
#pragma unroll
        for (int ai = 0; ai < 2; ++ai) {
            u32x4 yw[4][2], gw[4][2];
#pragma unroll
            for (int m = 0; m < 4; ++m) { const int row = row0 + ai * 128 + m * 16;
#pragma unroll
                for (int bj = 0; bj < 2; ++bj) { const int c = colb + bj * 128;
                    yw[m][bj] = *(const u32x4*)(Yg + ((size_t)(c >> 4) * M + row) * 16 + (c & 15));
                    gw[m][bj] = *(const u32x4*)(SG5 + (size_t)row * 1024 + c); } }
#pragma unroll
            for (int m = 0; m < 4; ++m) { const int row = row0 + ai * 128 + m * 16;
#pragma unroll
                for (int bj = 0; bj < 2; ++bj) { const int c = colb + bj * 128;
                    f32x4 y0, y1, g0, g1; unpack8(yw[m][bj], y0, y1); unpack8(gw[m][bj], g0, g1);
                    f32x4 z0 = acc[ai][bj][m][0] + bv[bj][0], z1 = acc[ai][bj][m][1] + bv[bj][1];
#pragma unroll
                    for (int i = 0; i < 4; ++i) { z0[i] = y0[i] * g0[i] * fsig2(z0[i], g0[i]); z1[i] = y1[i] * g1[i] * fsig2(z1[i], g1[i]); }
                    *(u32x4*)(Ymix + (size_t)row * 2048 + c) = pack8(z0, z1); } }
            asm volatile("" ::: "memory"); }
    }
};
struct EpiWout {
    static constexpr bool PERM = true;
    const float* X; bf16* X1B; float* ss1;
    __device__ __forceinline__ void operator()(const AccT& acc, const pg8::Unit& u, int wr, int wc, int fr, int fq) const {
        const int row0 = u.pm * 256 + wr * 64 + fr, colb = u.pn * 256 + wc * 32 + 8 * fq;
#pragma unroll
        for (int ai = 0; ai < 2; ++ai) {
            f32x4 xv[4][2][2];
#pragma unroll
            for (int m = 0; m < 4; ++m) { const size_t off = (size_t)(row0 + ai * 128 + m * 16) * 1024 + colb;
#pragma unroll
                for (int bj = 0; bj < 2; ++bj)
#pragma unroll
                    for (int n = 0; n < 2; ++n) xv[m][bj][n] = *(const f32x4*)(X + off + bj * 128 + 4 * n); }
#pragma unroll
            for (int m = 0; m < 4; ++m) { const int row = row0 + ai * 128 + m * 16; const size_t off = (size_t)row * 1024 + colb; float s = 0.f;
#pragma unroll
                for (int bj = 0; bj < 2; ++bj) { f32x4 x1[2];
#pragma unroll
                    for (int n = 0; n < 2; ++n) { x1[n] = xv[m][bj][n] + acc[ai][bj][m][n];
                        s += (x1[n][0] * x1[n][0] + x1[n][1] * x1[n][1]) + (x1[n][2] * x1[n][2] + x1[n][3] * x1[n][3]); }
                    *(u32x4*)(X1B + off + bj * 128) = pack8(x1[0], x1[1]); }
                s += __shfl_xor(s, 16); s += __shfl_xor(s, 32);
                if (fq == 0) atomicAdd(ss1 + row, s); }
            asm volatile("" ::: "memory"); }
    }
};
struct EpiWinC {
    static constexpr bool PERM = true;
    const float* ss1; bf16* U2; bf16* SG2;
    __device__ __forceinline__ void operator()(const AccT& acc, const pg8::Unit& u, int wr, int wc, int fr, int fq) const {
        const int pn = u.pn, row0 = u.pm * 256 + wr * 64 + fr;
        float rs[2][4];
#pragma unroll
        for (int ai = 0; ai < 2; ++ai)
#pragma unroll
            for (int m = 0; m < 4; ++m) rs[ai][m] = ss1[row0 + ai * 128 + m * 16];
#pragma unroll
        for (int ai = 0; ai < 2; ++ai)
#pragma unroll
            for (int m = 0; m < 4; ++m) { const int row = row0 + ai * 128 + m * 16; const float r = rsqrtf(rs[ai][m] * (1.0f / 1024.0f) + EPS);
                if (pn < 8) {
                    f32x4 a0 = acc[ai][0][m][0] * r, a1 = acc[ai][0][m][1] * r, b0 = acc[ai][1][m][0] * r, b1 = acc[ai][1][m][1] * r;
#pragma unroll
                    for (int i = 0; i < 4; ++i) { a0[i] *= fsigmoid(b0[i]); a1[i] *= fsigmoid(b1[i]); }
                    *(u32x4*)(U2 + (size_t)row * 1024 + pn * 128 + wc * 32 + 8 * fq) = pack8(a0, a1);
                } else {
#pragma unroll
                    for (int bj = 0; bj < 2; ++bj) { f32x4 v0 = acc[ai][bj][m][0] * r, v1 = acc[ai][bj][m][1] * r;
                        *(u32x4*)(SG2 + (size_t)row * 1024 + (pn - 8) * 256 + bj * 128 + wc * 32 + 8 * fq) = pack8(v0, v1); }
                } }
    }
};
struct EpiWoutC {
    static constexpr bool PERM = true;
    const bf16* X1B; float* O; const float* fg; float* ss2; unsigned* cnt;
    __device__ __forceinline__ void operator()(AccT& acc, const pg8::Unit& u, int wr, int wc, int fr, int fq) const {
        const int row0 = u.pm * 256 + wr * 64 + fr, colb = u.pn * 256 + wc * 32 + 8 * fq;
#pragma unroll
        for (int ai = 0; ai < 2; ++ai) {
            u32x4 xw[4][2];
#pragma unroll
            for (int m = 0; m < 4; ++m) { const size_t off = (size_t)(row0 + ai * 128 + m * 16) * 1024 + colb;
#pragma unroll
                for (int bj = 0; bj < 2; ++bj) xw[m][bj] = *(const u32x4*)(X1B + off + bj * 128); }
#pragma unroll
            for (int m = 0; m < 4; ++m) { const int row = row0 + ai * 128 + m * 16; float s = 0.f;
#pragma unroll
                for (int bj = 0; bj < 2; ++bj) { f32x4 xv2[2]; unpack8(xw[m][bj], xv2[0], xv2[1]);
#pragma unroll
                    for (int n = 0; n < 2; ++n) { const f32x4 x2 = xv2[n] + acc[ai][bj][m][n]; acc[ai][bj][m][n] = x2;
                        s += (x2[0] * x2[0] + x2[1] * x2[1]) + (x2[2] * x2[2] + x2[3] * x2[3]); } }
                s += __shfl_xor(s, 16); s += __shfl_xor(s, 32);
                if (fq == 0) atomicAdd(ss2 + row, s); }
            asm volatile("" ::: "memory"); }
        asm volatile("s_waitcnt vmcnt(0)" ::: "memory");
        unsigned* c = cnt + 64 * u.pm;
        if ((threadIdx.x & 63) == 0) __hip_atomic_fetch_add(c, 1u, __ATOMIC_RELAXED, __HIP_MEMORY_SCOPE_AGENT);
        { unsigned sp = 0; while (__hip_atomic_load(c, __ATOMIC_RELAXED, __HIP_MEMORY_SCOPE_AGENT) < 32u) { __builtin_amdgcn_s_sleep(2); if (++sp > (1u << 22)) break; } }
        __builtin_amdgcn_fence(__ATOMIC_ACQUIRE, "agent");
        f32x4 gv[2][2];
#pragma unroll
        for (int bj = 0; bj < 2; ++bj)
#pragma unroll
            for (int n = 0; n < 2; ++n) gv[bj][n] = *(const f32x4*)(fg + colb + bj * 128 + 4 * n);
#pragma unroll
        for (int ai = 0; ai < 2; ++ai)
#pragma unroll
            for (int m = 0; m < 4; ++m) { const int row = row0 + ai * 128 + m * 16; const size_t off = (size_t)row * 1024 + colb;
                const float r = rsqrtf(__hip_atomic_load(ss2 + row, __ATOMIC_RELAXED, __HIP_MEMORY_SCOPE_AGENT) * (1.0f / 1024.0f) + EPS);
#pragma unroll
                for (int bj = 0; bj < 2; ++bj)
#pragma unroll
                    for (int n = 0; n < 2; ++n) *(f32x4*)(O + off + bj * 128 + 4 * n) = acc[ai][bj][m][n] * r * gv[bj][n]; }
    }
};

#define LDS_WAIT() asm volatile("s_waitcnt lgkmcnt(0)" ::: "memory")
__device__ __forceinline__ int dest_row(int n, int mode) {
    if (mode == 1) { if (n >= 2048 && n < 3072) { const int d = n & 63; return (n & ~63) + 8 * ((d & 31) >> 2) + 4 * (d >> 5) + (d & 3); } return n; }
    if (mode == 2) { if (n < 1024) return 256 * (n >> 7) + (n & 127); if (n < 2048) { const int q = n - 1024; return 256 * (q >> 7) + 128 + (q & 127); } return n; }
    return n;
}
__device__ __forceinline__ void p0_transpose_item(const float* W, int K, int N, bf16* WT, int mode, LAS float* scr, int item, int lane, const float* kscale = nullptr) {
    const int nblk = N / 32, kb = item / nblk, nb = item % nblk, k0 = 64 * kb, n0 = 32 * nb;
    float wv[32];
#pragma unroll
    for (int i = 0; i < 32; ++i) wv[i] = W[(size_t)(k0 + 2 * i + (lane >> 5)) * N + n0 + (lane & 31)];
    if (kscale) {
#pragma unroll
        for (int i = 0; i < 32; ++i) wv[i] *= kscale[k0 + 2 * i + (lane >> 5)]; }
#pragma unroll
    for (int i = 0; i < 32; ++i) scr[(2 * i + (lane >> 5)) * 33 + (lane & 31)] = wv[i];
    LDS_WAIT(); asm volatile("" ::: "memory");
    const int c = lane & 7;
#pragma unroll
    for (int j = 0; j < 4; ++j) { const int n = (lane >> 3) + 8 * j; const LAS float* s = scr + (8 * c) * 33 + n;
        u32x4 o; o.x = pk2(s[0 * 33], s[1 * 33]); o.y = pk2(s[2 * 33], s[3 * 33]); o.z = pk2(s[4 * 33], s[5 * 33]); o.w = pk2(s[6 * 33], s[7 * 33]);
        *(u32x4*)(WT + (size_t)dest_row(n0 + n, mode) * K + k0 + 8 * c) = o; }
    LDS_WAIT(); asm volatile("" ::: "memory");
}
__device__ __forceinline__ void rms_row_to_bf16(const float* xrow, const float* g, bf16* orow, int lane) {
    const f32x4* xr = (const f32x4*)xrow + lane; const f32x4* gr = (const f32x4*)g + lane;
    f32x4 v[4]; float s = 0.f;
#pragma unroll
    for (int j = 0; j < 4; ++j) { v[j] = xr[64 * j]; s += (v[j][0] * v[j][0] + v[j][1] * v[j][1]) + (v[j][2] * v[j][2] + v[j][3] * v[j][3]); }
    const float r = rsqrtf(wave_sum(s) * (1.f / 1024.f) + EPS);
    u32x2* o8 = (u32x2*)orow + lane;
#pragma unroll
    for (int j = 0; j < 4; ++j) { const f32x4 gg = gr[64 * j]; u32x2 w; w.x = pk2(v[j][0] * r * gg[0], v[j][1] * r * gg[1]); w.y = pk2(v[j][2] * r * gg[2], v[j][3] * r * gg[3]); o8[64 * j] = w; }
}
__device__ __forceinline__ void rms_rows2_to_bf16(const float* x0, const float* x1, const float* g, bf16* o0, bf16* o1, int lane) {
    const f32x4* xa = (const f32x4*)x0 + lane; const f32x4* xb = (const f32x4*)x1 + lane; const f32x4* gr = (const f32x4*)g + lane;
    f32x4 va[4], vb[4]; float sa = 0.f, sb = 0.f;
#pragma unroll
    for (int j = 0; j < 4; ++j) { va[j] = xa[64 * j]; vb[j] = xb[64 * j]; }
#pragma unroll
    for (int j = 0; j < 4; ++j) { sa += (va[j][0] * va[j][0] + va[j][1] * va[j][1]) + (va[j][2] * va[j][2] + va[j][3] * va[j][3]); sb += (vb[j][0] * vb[j][0] + vb[j][1] * vb[j][1]) + (vb[j][2] * vb[j][2] + vb[j][3] * vb[j][3]); }
#pragma unroll
    for (int o = 1; o < 64; o <<= 1) { sa += __shfl_xor(sa, o); sb += __shfl_xor(sb, o); }
    const float ra = rsqrtf(sa * (1.f / 1024.f) + EPS), rb = rsqrtf(sb * (1.f / 1024.f) + EPS);
    u32x2* pa = (u32x2*)o0 + lane; u32x2* pb = (u32x2*)o1 + lane;
#pragma unroll
    for (int j = 0; j < 4; ++j) { const f32x4 gg = gr[64 * j]; u32x2 w;
        w.x = pk2(va[j][0] * ra * gg[0], va[j][1] * ra * gg[1]); w.y = pk2(va[j][2] * ra * gg[2], va[j][3] * ra * gg[3]); pa[64 * j] = w;
        w.x = pk2(vb[j][0] * rb * gg[0], vb[j][1] * rb * gg[1]); w.y = pk2(vb[j][2] * rb * gg[2], vb[j][3] * rb * gg[3]); pb[64 * j] = w; }
}
__device__ __forceinline__ void rms_row_f32(float* xrow, const float* g, int lane) {
    f32x4* xr = (f32x4*)xrow + lane; const f32x4* gr = (const f32x4*)g + lane;
    f32x4 v[4]; float s = 0.f;
#pragma unroll
    for (int j = 0; j < 4; ++j) { v[j] = xr[64 * j]; s += (v[j][0] * v[j][0] + v[j][1] * v[j][1]) + (v[j][2] * v[j][2] + v[j][3] * v[j][3]); }
    const float r = rsqrtf(wave_sum(s) * (1.f / 1024.f) + EPS);
#pragma unroll
    for (int j = 0; j < 4; ++j) xr[64 * j] = v[j] * r * gr[64 * j];
}

__device__ __forceinline__ void cpow_table(float rho, float theta, int k, float& pr, float& pi) {
    const float mag = __expf(rho * (float)k);
    const double ang = (double)theta * (double)k; const double tw = 6.283185307179586476925286766559;
    const float red = (float)(ang - tw * __builtin_rint(ang / tw));
    pr = mag * cosf(red); pi = mag * sinf(red);
}
__device__ __forceinline__ void s5_tables_item(int item, LAS float* L, const float* a_re, const float* a_im, const float* log_dt, const float* b_re, const float* b_im,
                                               const float* c_re, const float* c_im, const float* dskip, bf16* Tg, bf16* Wg, float* L16, int tid) {
    const int g = item >> 2, kq = item & 3;
    LAS float* PWr = L; LAS float* PWi = L + 320;
    LAS float* cfr = L + 640; LAS float* cfi = L + 704;
    LAS float* Bbr = L + 768; LAS float* Bbi = Bbr + 1024; LAS float* Cr = Bbi + 1024; LAS float* Ci = Cr + 1024; LAS float* Kk = Ci + 1024;
    float brv[2], biv[2];
#pragma unroll
    for (int i = 0; i < 2; ++i) { const int e = tid + NTHR * i; Cr[e] = c_re[g * 1024 + e]; Ci[e] = c_im[g * 1024 + e]; brv[i] = b_re[g * 1024 + e]; biv[i] = b_im[g * 1024 + e]; }
    if (tid < 64) { const int n = tid; const float are = a_re[g * 64 + n], aim = a_im[g * 64 + n], dt = expf(log_dt[g]);
        const float rho = are * dt, theta = aim * dt;
        float lr, li; cpow_table(rho, theta, 1, lr, li);
        const float sh = sinf(0.5f * theta);
        const float nr = expm1f(rho) * cosf(theta) - 2.0f * sh * sh, ni = li;
        const float den = are * are + aim * aim;
        cfr[n] = (nr * are + ni * aim) / den; cfi[n] = (ni * are - nr * aim) / den;
#pragma unroll
        for (int j = 0; j < 5; ++j) { float pr, pi; cpow_table(rho, theta, 4 * kq + j, pr, pi); PWr[j * 64 + n] = pr; PWi[j * 64 + n] = pi;
            if (4 * kq + j == 16) { L16[g * 128 + n] = pr; L16[g * 128 + 64 + n] = pi; } }
    }
    __syncthreads();
#pragma unroll
    for (int i = 0; i < 2; ++i) { const int e = tid + NTHR * i, n = e >> 4; Bbr[e] = cfr[n] * brv[i] - cfi[n] * biv[i]; Bbi[e] = cfr[n] * biv[i] + cfi[n] * brv[i]; }
    __syncthreads();
    bf16* Tgg = Tg + (size_t)g * 256 * AEXT_LD;
    for (int kk = 0; kk < 4; ++kk) {
        const int k = 4 * kq + kk;
        const LAS float* Lkr = PWr + kk * 64; const LAS float* Lki = PWi + kk * 64; const LAS float* L1r = PWr + (kk + 1) * 64; const LAS float* L1i = PWi + (kk + 1) * 64;
        if (tid < 256) { const int ho = tid >> 4, hi = tid & 15; float sacc = 0.f;
            for (int n = 0; n < 64; ++n) { const float clr = Cr[ho * 64 + n] * Lkr[n] - Ci[ho * 64 + n] * Lki[n], cli = Cr[ho * 64 + n] * Lki[n] + Ci[ho * 64 + n] * Lkr[n];
                sacc += clr * Bbr[n * 16 + hi] - cli * Bbi[n * 16 + hi]; }
            if (k == 0 && ho == hi) sacc += dskip[g * 16 + ho];
            Kk[tid] = sacc; }
        __syncthreads();
        {
            const int bi = tid >> 5, ho = (tid & 31) >> 1, h8 = (tid & 1) * 8;
            if (bi >= k) { const int to = bi, ti = bi - k; const LAS float* sp = Kk + ho * 16 + h8;
                u32x4 w; w.x = pk2(sp[0], sp[1]); w.y = pk2(sp[2], sp[3]); w.z = pk2(sp[4], sp[5]); w.w = pk2(sp[6], sp[7]);
                *(u32x4*)(Tgg + (size_t)(to * 16 + ho) * AEXT_LD + ti * 16 + h8) = w; }
            if (k >= 1 && bi + k <= 15) { const int to = bi, ti = bi + k; *(u32x4*)(Tgg + (size_t)(to * 16 + ho) * AEXT_LD + ti * 16 + h8) = (u32x4){0u, 0u, 0u, 0u}; }
        }
        for (int e = tid; e < 1024; e += NTHR) { const int ho = e >> 6, n = e & 63;
            const float vr = Cr[e] * L1r[n] - Ci[e] * L1i[n], vi = Cr[e] * L1i[n] + Ci[e] * L1r[n];
            bf16* rowp = Tgg + (size_t)(k * 16 + ho) * AEXT_LD + 256;
            rowp[n] = (bf16)f2bf(vr); rowp[64 + n] = (bf16)f2bf(-vi); }
        {
            const int np = tid >> 1, h8 = (tid & 1) * 8, ti = 15 - k; float v[8];
#pragma unroll
            for (int x = 0; x < 8; ++x) { float val = 0.f;
                if (np < 128) { const int n = np & 63; const float br = Bbr[n * 16 + h8 + x], bi2 = Bbi[n * 16 + h8 + x];
                    val = np < 64 ? (Lkr[n] * br - Lki[n] * bi2) : (Lkr[n] * bi2 + Lki[n] * br); }
                v[x] = val; }
            u32x4 w; w.x = pk2(v[0], v[1]); w.y = pk2(v[2], v[3]); w.z = pk2(v[4], v[5]); w.w = pk2(v[6], v[7]);
            *(u32x4*)(Wg + ((size_t)g * 256 + np) * 256 + ti * 16 + h8) = w;
        }
        __syncthreads();
    }
}

__device__ __forceinline__ void s5_scan_item(int item, LAS float* L, const float* Sloc, const float* L16, bf16* Aext, int tid) {
    const int g = item >> 3, b = item & 7, seg = tid >> 6, n = tid & 63;
    const float ar = L16[g * 128 + n], ai = L16[g * 128 + 64 + n];
    const float* sl = Sloc + (size_t)(g * 2048 + b * 256 + seg * 32) * 128 + n;
    float srv[32], siv[32];
#pragma unroll
    for (int c = 0; c < 32; ++c) { srv[c] = sl[c * 128]; siv[c] = sl[c * 128 + 64]; }
    float er = 0.f, ei = 0.f;
#pragma unroll
    for (int c = 0; c < 32; ++c) { const float t = ar * er - ai * ei + srv[c]; ei = ar * ei + ai * er + siv[c]; er = t; }
    float pr = ar, pi = ai;
#pragma unroll
    for (int i = 0; i < 5; ++i) { const float t = pr * pr - pi * pi; pi = 2.f * pr * pi; pr = t; }
    L[(seg * 64 + n) * 2] = er; L[(seg * 64 + n) * 2 + 1] = ei;
    __syncthreads();
    float xr = 0.f, xi = 0.f;
    for (int s = 0; s < seg; ++s) { const float qr = L[(s * 64 + n) * 2], qi = L[(s * 64 + n) * 2 + 1]; const float t = pr * xr - pi * xi + qr; xi = pr * xi + pi * xr + qi; xr = t; }
    bf16* dst = Aext + (size_t)(g * 2048 + b * 256 + seg * 32) * AEXT_LD + 256 + n;
#pragma unroll
    for (int c = 0; c < 32; ++c) {
        dst[c * AEXT_LD] = (bf16)f2bf(xr); dst[c * AEXT_LD + 64] = (bf16)f2bf(xi);
        const float t = ar * xr - ai * xi + srv[c]; xi = ar * xi + ai * xr + siv[c]; xr = t; }
    __syncthreads();
}

constexpr int WB_P = 264;
constexpr int SL_P = 132;
__device__ __forceinline__ void s5_state_item(int item, LAS unsigned char* lds, const bf16* Wg, const float* L16, bf16* Aext, int tid) {
    const int g = item >> 3, b = item & 7;
    const int wid = tid >> 6, lane = tid & 63, l15 = lane & 15, g4 = lane >> 4, n = lane;
    LAS bf16* WB = (LAS bf16*)lds;
    LAS float* SL = (LAS float*)(lds + 128 * WB_P * 2);
    LAS float* EX = SL + 128 * SL_P;
    const bf16* wsrc = Wg + (size_t)g * 256 * 256;
#pragma unroll
    for (int i = 0; i < 8; ++i) { const int p = tid + 512 * i, row = p >> 5, cp = p & 31; *(LAS u32x4*)(WB + row * WB_P + cp * 8) = *(const u32x4*)(wsrc + row * 256 + cp * 8); }
    const bf16* arow = Aext + (size_t)(g * 2048 + b * 256) * AEXT_LD;
    bf16x8 af[2][8];
#pragma unroll
    for (int hf = 0; hf < 2; ++hf)
#pragma unroll
        for (int ks = 0; ks < 8; ++ks) af[hf][ks] = *(const bf16x8*)(arow + (size_t)(hf * 128 + wid * 16 + l15) * AEXT_LD + ks * 32 + 8 * g4);
    const float ar = L16[g * 128 + n], ai = L16[g * 128 + 64 + n];
    float pr = ar, pi = ai;
#pragma unroll
    for (int i = 0; i < 4; ++i) { const float t = pr * pr - pi * pi; pi = 2.f * pr * pi; pr = t; }
    float cr = 0.f, ci = 0.f;
    __syncthreads();
#pragma unroll
    for (int hf = 0; hf < 2; ++hf) {
        f32x4 acc[8];
#pragma unroll
        for (int nt = 0; nt < 8; ++nt) acc[nt] = (f32x4){0.f, 0.f, 0.f, 0.f};
#pragma unroll
        for (int ks = 0; ks < 8; ++ks)
#pragma unroll
            for (int nt = 0; nt < 8; ++nt) { const bf16x8 bfr = *(const LAS bf16x8*)(WB + (nt * 16 + l15) * WB_P + ks * 32 + 8 * g4);
                acc[nt] = __builtin_amdgcn_mfma_f32_16x16x32_bf16(af[hf][ks], bfr, acc[nt], 0, 0, 0); }
#pragma unroll
        for (int nt = 0; nt < 8; ++nt)
#pragma unroll
            for (int r = 0; r < 4; ++r) SL[(wid * 16 + 4 * g4 + r) * SL_P + nt * 16 + l15] = acc[nt][r];
        __syncthreads();
        float srv[16], siv[16]; float er = 0.f, ei = 0.f;
#pragma unroll
        for (int c = 0; c < 16; ++c) { srv[c] = SL[(wid * 16 + c) * SL_P + n]; siv[c] = SL[(wid * 16 + c) * SL_P + 64 + n]; }
#pragma unroll
        for (int c = 0; c < 16; ++c) { const float t = ar * er - ai * ei + srv[c]; ei = ar * ei + ai * er + siv[c]; er = t; }
        EX[(wid * 64 + n) * 2] = er; EX[(wid * 64 + n) * 2 + 1] = ei;
        __syncthreads();
        float xr = cr, xi = ci;
        for (int sg = 0; sg < wid; ++sg) { const float qr = EX[(sg * 64 + n) * 2], qi = EX[(sg * 64 + n) * 2 + 1]; const float t = pr * xr - pi * xi + qr; xi = pr * xi + pi * xr + qi; xr = t; }
        bf16* dst = Aext + (size_t)(g * 2048 + b * 256 + hf * 128 + wid * 16) * AEXT_LD + 256 + n;
#pragma unroll
        for (int c = 0; c < 16; ++c) {
            dst[c * AEXT_LD] = (bf16)f2bf(xr); dst[c * AEXT_LD + 64] = (bf16)f2bf(xi);
            const float t = ar * xr - ai * xi + srv[c]; xi = ar * xi + ai * xr + siv[c]; xr = t; }
        if (wid == 7) { EX[(8 * 64 + n) * 2] = xr; EX[(8 * 64 + n) * 2 + 1] = xi; }
        __syncthreads();
        cr = EX[(8 * 64 + n) * 2]; ci = EX[(8 * 64 + n) * 2 + 1];
    }
    __syncthreads();
}

constexpr int TB_P = 392;
constexpr int OT_P = 136;
__device__ __forceinline__ void s5_out_item(int item, LAS unsigned char* lds, const bf16* Tg, const bf16* Aext, bf16* Yg, int tid) {
    const int g = item >> 3, b = item & 7;
    const int wid = tid >> 6, lane = tid & 63, l15 = lane & 15, g4 = lane >> 4;
    LAS bf16* TB = (LAS bf16*)lds;
    const bf16* arow = Aext + (size_t)(g * 2048 + b * 256 + wid * 32) * AEXT_LD;
    bf16x8 af[2][12];
#pragma unroll
    for (int rt = 0; rt < 2; ++rt)
#pragma unroll
        for (int ks = 0; ks < 12; ++ks) af[rt][ks] = *(const bf16x8*)(arow + (size_t)(rt * 16 + l15) * AEXT_LD + ks * 32 + 8 * g4);
    bf16* ybase = Yg + (size_t)(g * 2048 + b * 256) * 256;
#pragma unroll 1
    for (int nh = 0; nh < 2; ++nh) {
        const bf16* tsrc = Tg + ((size_t)g * 256 + nh * 128) * AEXT_LD;
        __syncthreads();
#pragma unroll 1
        for (int i0 = 0; i0 < 12; i0 += 4) { u32x4 tv[4];
#pragma unroll
            for (int i = 0; i < 4; ++i) { const int p = tid + 512 * (i0 + i), row = p / 48, cp = p % 48; tv[i] = *(const u32x4*)(tsrc + (size_t)row * AEXT_LD + cp * 8); }
#pragma unroll
            for (int i = 0; i < 4; ++i) { const int p = tid + 512 * (i0 + i), row = p / 48, cp = p % 48; *(LAS u32x4*)(TB + row * TB_P + cp * 8) = tv[i]; } }
        __syncthreads();
        f32x4 acc[2][8];
#pragma unroll
        for (int rt = 0; rt < 2; ++rt)
#pragma unroll
            for (int nt = 0; nt < 8; ++nt) acc[rt][nt] = (f32x4){0.f, 0.f, 0.f, 0.f};
#pragma unroll
        for (int ks = 0; ks < 12; ++ks)
#pragma unroll
            for (int nt = 0; nt < 8; ++nt) { const bf16x8 tf = *(const LAS bf16x8*)(TB + (nt * 16 + l15) * TB_P + ks * 32 + 8 * g4);
                acc[0][nt] = __builtin_amdgcn_mfma_f32_16x16x32_bf16(tf, af[0][ks], acc[0][nt], 0, 0, 0);
                acc[1][nt] = __builtin_amdgcn_mfma_f32_16x16x32_bf16(tf, af[1][ks], acc[1][nt], 0, 0, 0); }
        __syncthreads();
        LAS bf16* OT = TB;
#pragma unroll
        for (int rt = 0; rt < 2; ++rt)
#pragma unroll
            for (int nt = 0; nt < 8; ++nt) { const f32x4 v = acc[rt][nt]; u32x2 w; w.x = pk2(fgelu_tanh(v[0]), fgelu_tanh(v[1])); w.y = pk2(fgelu_tanh(v[2]), fgelu_tanh(v[3]));
                *(LAS u32x2*)(OT + (wid * 32 + rt * 16 + l15) * OT_P + nt * 16 + 4 * g4) = w; }
#pragma unroll
        for (int i = 0; i < 8; ++i) { const int pp = lane + 64 * i, row = pp >> 4, cp = pp & 15;
            const u32x4 w = *(const LAS u32x4*)(OT + (wid * 32 + row) * OT_P + cp * 8);
            *(u32x4*)(ybase + (size_t)(wid * 32 + row) * 256 + nh * 128 + cp * 8) = w; }
    }
    __syncthreads();
}

typedef short s16x4 __attribute__((ext_vector_type(4)));
constexpr int RP = 72, RPV = 152;
__device__ __forceinline__ bf16x8 tr_frag8(LAS bf16* p0, int pitch) {
    const s16x4 a = __builtin_amdgcn_ds_read_tr16_b64_v4i16((LAS s16x4*)p0);
    const s16x4 b = __builtin_amdgcn_ds_read_tr16_b64_v4i16((LAS s16x4*)(p0 + 4 * pitch));
    return (bf16x8){a[0], a[1], a[2], a[3], b[0], b[1], b[2], b[3]};
}
template <bool FULL>
__device__ __forceinline__ void retention_item(int item, LAS unsigned char* lds, const bf16* Q, const bf16* Kb, const bf16* V, const bf16* SGR, float* KVseg, bf16* Ymix, int tid) {
    const int b = item >> 5, h = (item >> 2) & 7, seg = item & 3;
    const int wid = tid >> 6, lane = tid & 63, l15 = lane & 15, q4 = lane >> 4, tq = (lane & 15) >> 2, tp = lane & 3;
    LAS bf16* Qs = (LAS bf16*)lds; LAS bf16* Ks = Qs + 64 * RP; LAS bf16* KPs = Ks + 64 * RP; LAS bf16* Vs = KPs + 64 * RP;
    LAS bf16* Ps = Vs + 64 * RPV; LAS bf16* STs = Ps + 64 * RP; LAS float* stat = (LAS float*)(STs + 128 * RP);
    const float lg2 = log2f(1.0f - exp2f(-5.0f - (float)h));
    const float d64 = exp2f(lg2 * 64.0f);
    const int db = wid >> 1, ib = wid >> 1, hf = wid & 1, et0 = hf * 4;
    f32x4 Sacc[4];
#pragma unroll
    for (int t = 0; t < 4; ++t) Sacc[t] = (f32x4){0.f, 0.f, 0.f, 0.f};
    if (FULL) {
        const float w1024 = exp2f(lg2 * 1024.0f); float wgt = 1.0f;
        for (int s = seg - 1; s >= 0; --s) { const float* kv = KVseg + (size_t)((b * 8 + h) * 4 + s) * 8192;
#pragma unroll
            for (int t = 0; t < 4; ++t)
#pragma unroll
                for (int r = 0; r < 4; ++r) Sacc[t][r] += wgt * kv[(db * 16 + 4 * q4 + r) * 128 + (et0 + t) * 16 + l15];
            wgt *= w1024; }
#pragma unroll
        for (int t = 0; t < 4; ++t) { u32x2 w; w.x = pk2(Sacc[t][0], Sacc[t][1]); w.y = pk2(Sacc[t][2], Sacc[t][3]); *(LAS u32x2*)(STs + ((et0 + t) * 16 + l15) * RP + db * 16 + 4 * q4) = w; }
    }
    const int tok_seg = b * SEQ + seg * 1024;
    const int lrow = tid >> 3, lcp = tid & 7;
    const bf16* kptr = Kb + (size_t)(tok_seg + lrow) * 512 + h * 64 + lcp * 8;
    const bf16* qptr = Q + (size_t)(tok_seg + lrow) * 512 + h * 64 + lcp * 8;
    const bf16* vptr = V + (size_t)(tok_seg + (tid >> 4)) * 1024 + h * 128 + (tid & 15) * 8;
    const float kd = exp2f(lg2 * (float)(63 - lrow));
    const float qd = exp2f(lg2 * (float)(ib * 16 + l15 + 1));
    constexpr int PF = FULL ? 2 : 4;
    const bf16* gptr = SGR + (size_t)(tok_seg + ib * 16 + l15) * 1024 + h * 128 + et0 * 16 + 4 * q4;
    u32x4 kwS[PF], qwS[PF], vw0S[PF], vw1S[PF];
#pragma unroll
    for (int u = 0; u < PF; ++u) { const size_t o5 = (size_t)u * 64 * 512, o10 = (size_t)u * 64 * 1024;
        kwS[u] = *(const u32x4*)(kptr + o5); vw0S[u] = *(const u32x4*)(vptr + o10); vw1S[u] = *(const u32x4*)(vptr + o10 + 32 * 1024);
        if (FULL) qwS[u] = *(const u32x4*)(qptr + o5); }
    const int trV = (8 * q4 + tq) * RPV + 4 * tp, trK = (8 * q4 + tq) * RP + 4 * tp;
    float dec[2][4];
#pragma unroll
    for (int jj = 0; jj < 2; ++jj)
#pragma unroll
        for (int r = 0; r < 4; ++r) { const int dist = (ib * 16 + l15) - ((hf * 2 + jj) * 16 + 4 * q4 + r); dec[jj][r] = exp2f(lg2 * (float)(dist < 0 ? -dist : dist)); }
    for (int c0 = 0; c0 < 16; c0 += PF) {
#pragma unroll
      for (int u = 0; u < PF; ++u) {
        const int ch = c0 + u;
        const int tok0 = tok_seg + ch * 64;
        u32x2 gw[4];
        if (FULL) {
#pragma unroll
            for (int t = 0; t < 4; ++t) gw[t] = *(const u32x2*)(gptr + (size_t)ch * 64 * 1024 + t * 16); }
        {
            const u32x4 kw = kwS[u];
            if (FULL) { *(LAS u32x4*)(Ks + lrow * RP + lcp * 8) = kw; *(LAS u32x4*)(Qs + lrow * RP + lcp * 8) = qwS[u]; }
            f32x4 k0, k1; unpack8(kw, k0, k1); *(LAS u32x4*)(KPs + lrow * RP + lcp * 8) = pack8(k0 * kd, k1 * kd);
            *(LAS u32x4*)(Vs + (tid >> 4) * RPV + (tid & 15) * 8) = vw0S[u]; *(LAS u32x4*)(Vs + ((tid >> 4) + 32) * RPV + (tid & 15) * 8) = vw1S[u];
            if (ch + PF < 16) { const size_t o5 = (size_t)(ch + PF) * 64 * 512, o10 = (size_t)(ch + PF) * 64 * 1024;
                kwS[u] = *(const u32x4*)(kptr + o5); vw0S[u] = *(const u32x4*)(vptr + o10); vw1S[u] = *(const u32x4*)(vptr + o10 + 32 * 1024);
                if (FULL) qwS[u] = *(const u32x4*)(qptr + o5); }
        }
        __syncthreads();
        if (FULL) {
#pragma unroll
            for (int jj = 0; jj < 2; ++jj) { const int jb = hf * 2 + jj; f32x4 sacc = (f32x4){0.f, 0.f, 0.f, 0.f};
#pragma unroll
                for (int ks = 0; ks < 2; ++ks) { const bf16x8 af = *(const LAS bf16x8*)(Ks + (jb * 16 + l15) * RP + ks * 32 + 8 * q4); const bf16x8 bfr = *(const LAS bf16x8*)(Qs + (ib * 16 + l15) * RP + ks * 32 + 8 * q4);
                    sacc = __builtin_amdgcn_mfma_f32_16x16x32_bf16(af, bfr, sacc, 0, 0, 0); }
                const int i = ib * 16 + l15, j0 = jb * 16 + 4 * q4; float pv[4];
#pragma unroll
                for (int r = 0; r < 4; ++r) pv[r] = sacc[r] * dec[jj][r];
                u32x2 w; w.x = pk2(pv[0], pv[1]); w.y = pk2(pv[2], pv[3]); *(LAS u32x2*)(Ps + i * RP + j0) = w; }
        }
        bf16x8 vf[2][4];
#pragma unroll
        for (int ks = 0; ks < 2; ++ks)
#pragma unroll
            for (int t = 0; t < 4; ++t) vf[ks][t] = tr_frag8(Vs + ks * 32 * RPV + (et0 + t) * 16 + trV, RPV);
#pragma unroll
        for (int t = 0; t < 4; ++t) Sacc[t] = Sacc[t] * d64;
#pragma unroll
        for (int ks = 0; ks < 2; ++ks) { const bf16x8 kf = tr_frag8(KPs + ks * 32 * RP + db * 16 + trK, RP);
#pragma unroll
            for (int t = 0; t < 4; ++t) Sacc[t] = __builtin_amdgcn_mfma_f32_16x16x32_bf16(kf, vf[ks][t], Sacc[t], 0, 0, 0); }
        if (FULL) {
            __syncthreads();
            f32x4 oacc[4], cacc[4];
#pragma unroll
            for (int t = 0; t < 4; ++t) { oacc[t] = (f32x4){0.f, 0.f, 0.f, 0.f}; cacc[t] = (f32x4){0.f, 0.f, 0.f, 0.f}; }
#pragma unroll
            for (int ks = 0; ks < 2; ++ks) { const bf16x8 pb = *(const LAS bf16x8*)(Ps + (ib * 16 + l15) * RP + ks * 32 + 8 * q4); const bf16x8 qb = *(const LAS bf16x8*)(Qs + (ib * 16 + l15) * RP + ks * 32 + 8 * q4);
#pragma unroll
                for (int t = 0; t < 4; ++t) { const bf16x8 sa = *(const LAS bf16x8*)(STs + ((et0 + t) * 16 + l15) * RP + ks * 32 + 8 * q4);
                    oacc[t] = __builtin_amdgcn_mfma_f32_16x16x32_bf16(vf[ks][t], pb, oacc[t], 0, 0, 0); cacc[t] = __builtin_amdgcn_mfma_f32_16x16x32_bf16(sa, qb, cacc[t], 0, 0, 0); } }
            float s = 0.f, sq = 0.f;
#pragma unroll
            for (int t = 0; t < 4; ++t)
#pragma unroll
                for (int r = 0; r < 4; ++r) { const float o = oacc[t][r] + qd * cacc[t][r]; oacc[t][r] = o; s += o; sq += o * o; }
            s += __shfl_xor(s, 16); sq += __shfl_xor(sq, 16); s += __shfl_xor(s, 32); sq += __shfl_xor(sq, 32);
            const int i = ib * 16 + l15;
            if (q4 == 0) { *(LAS f32x2*)(stat + (i * 2 + hf) * 2) = (f32x2){s, sq}; }
            __syncthreads();
#pragma unroll
            for (int t = 0; t < 4; ++t) { u32x2 w; w.x = pk2(Sacc[t][0], Sacc[t][1]); w.y = pk2(Sacc[t][2], Sacc[t][3]); *(LAS u32x2*)(STs + ((et0 + t) * 16 + l15) * RP + db * 16 + 4 * q4) = w; }
            const f32x4 st = *(const LAS f32x4*)(stat + i * 4);
            const float mean = (st[0] + st[2]) * (1.f / 128.f); const float var = (st[1] + st[3]) * (1.f / 128.f) - mean * mean; const float rstd = rsqrtf(fmaxf(var, 0.f) + EPS);
            bf16* orow = Ymix + (size_t)(tok0 + i) * 2048 + 1024 + h * 128 + et0 * 16 + 4 * q4;
#pragma unroll
            for (int t = 0; t < 4; ++t) { const float g0 = bf2f(gw[t].x & 0xffffu), g1 = bf2f(gw[t].x >> 16), g2 = bf2f(gw[t].y & 0xffffu), g3 = bf2f(gw[t].y >> 16);
                u32x2 w; w.x = pk2((oacc[t][0] - mean) * rstd * g0, (oacc[t][1] - mean) * rstd * g1); w.y = pk2((oacc[t][2] - mean) * rstd * g2, (oacc[t][3] - mean) * rstd * g3);
                *(u32x2*)(orow + t * 16) = w; }
        }
        __syncthreads();
      }
    }
    if (!FULL) { float* kv = KVseg + (size_t)item * 8192;
#pragma unroll
        for (int t = 0; t < 4; ++t)
#pragma unroll
            for (int r = 0; r < 4; ++r) kv[(db * 16 + 4 * q4 + r) * 128 + (et0 + t) * 16 + l15] = Sacc[t][r]; }
}

constexpr int RPP = 136;
__device__ __forceinline__ void retention_full_item(const int MODE, int item, LAS unsigned char* lds, const bf16* Q, const bf16* Kb, const bf16* V, const bf16* SGR, const float* KVseg, bf16* Ymix, int tid) {
    const int b = item >> 5, h = (item >> 2) & 7, seg = item & 3;
    const int wid = __builtin_amdgcn_readfirstlane(tid >> 6), lane = tid & 63, l15 = lane & 15, q4 = lane >> 4, tq = (lane & 15) >> 2, tp = lane & 3;
    LAS bf16* Qs = (LAS bf16*)lds; LAS bf16* Ks = Qs + 128 * RP; LAS bf16* KPs = Ks + 128 * RP; LAS bf16* Vs = KPs + 128 * RP;
    LAS bf16* Ps = Vs + 128 * RPV; LAS bf16* STs = Ps + 128 * RPP;
    const float lg2 = log2f(1.0f - exp2f(-5.0f - (float)h));
    const float d128 = exp2f(lg2 * 128.0f);
    const int db = wid >> 1, et0 = (wid & 1) * 4;
    const int irow = wid * 16 + l15;
    const bool second = wid >= 4;
    f32x4 Sacc[4];
#pragma unroll
    for (int t = 0; t < 4; ++t) Sacc[t] = (f32x4){0.f, 0.f, 0.f, 0.f};
    {
        const float w1024 = exp2f(lg2 * 1024.0f); float wgt = 1.0f;
        for (int s = seg - 1; s >= 0; --s) { const float* kv = KVseg + (size_t)((b * 8 + h) * 4 + s) * 8192;
#pragma unroll
            for (int t = 0; t < 4; ++t)
#pragma unroll
                for (int r = 0; r < 4; ++r) Sacc[t][r] += wgt * kv[(db * 16 + 4 * q4 + r) * 128 + (et0 + t) * 16 + l15];
            wgt *= w1024; }
#pragma unroll
        for (int t = 0; t < 4; ++t) { u32x2 w; w.x = pk2(Sacc[t][0], Sacc[t][1]); w.y = pk2(Sacc[t][2], Sacc[t][3]); *(LAS u32x2*)(STs + ((et0 + t) * 16 + l15) * RP + db * 16 + 4 * q4) = w; }
    }
    const int tok_seg = b * SEQ + seg * 1024;
    const int krow = tid >> 3, kcp = tid & 7, vrow = tid >> 4, vcp = tid & 15;
    const bf16* kptr = Kb + (size_t)(tok_seg + krow) * 512 + h * 64 + kcp * 8;
    const bf16* qptr = Q + (size_t)(tok_seg + krow) * 512 + h * 64 + kcp * 8;
    const bf16* vptr = V + (size_t)(tok_seg + vrow) * 1024 + h * 128 + vcp * 8;
    const bf16* gptr2 = SGR + (size_t)(tok_seg + wid * 16 + q4) * 1024 + h * 128 + l15 * 8;
    bf16* optr2 = Ymix + (size_t)(tok_seg + wid * 16 + q4) * 2048 + 1024 + h * 128 + l15 * 8;
    const float kd0 = exp2f(lg2 * (float)(127 - krow)), kd1 = exp2f(lg2 * (float)(63 - krow));
    const float qd = exp2f(lg2 * (float)(irow + 1));
    u32x4 kw[2], qw[2], vw[4];
#pragma unroll
    for (int i = 0; i < 2; ++i) { kw[i] = *(const u32x4*)(kptr + (size_t)i * 64 * 512); qw[i] = *(const u32x4*)(qptr + (size_t)i * 64 * 512); }
#pragma unroll
    for (int i = 0; i < 4; ++i) vw[i] = *(const u32x4*)(vptr + (size_t)i * 32 * 1024);
    const int trV = (8 * q4 + tq) * RPV + 4 * tp, trK = (8 * q4 + tq) * RP + 4 * tp;
#pragma unroll 1
    for (int it = 0; it < 8; ++it) {
        {
#pragma unroll
            for (int i = 0; i < 2; ++i) { const int row = krow + 64 * i;
                *(LAS u32x4*)(Ks + row * RP + kcp * 8) = kw[i]; *(LAS u32x4*)(Qs + row * RP + kcp * 8) = qw[i];
                f32x4 k0, k1; unpack8(kw[i], k0, k1); const float kd = i == 0 ? kd0 : kd1; *(LAS u32x4*)(KPs + row * RP + kcp * 8) = pack8(k0 * kd, k1 * kd); }
#pragma unroll
            for (int i = 0; i < 4; ++i) *(LAS u32x4*)(Vs + (vrow + 32 * i) * RPV + vcp * 8) = vw[i];
            if (it < 7 && MODE < 2) { const size_t o5 = (size_t)(it + 1) * 128 * 512, o10 = (size_t)(it + 1) * 128 * 1024;
#pragma unroll
                for (int i = 0; i < 2; ++i) { kw[i] = *(const u32x4*)(kptr + o5 + (size_t)i * 64 * 512); qw[i] = *(const u32x4*)(qptr + o5 + (size_t)i * 64 * 512); }
#pragma unroll
                for (int i = 0; i < 4; ++i) vw[i] = *(const u32x4*)(vptr + o10 + (size_t)i * 32 * 1024); }
        }
        __syncthreads();
        if (MODE < 3)
        {
            bf16x8 qf[2];
#pragma unroll
            for (int ks = 0; ks < 2; ++ks) qf[ks] = *(const LAS bf16x8*)(Qs + irow * RP + ks * 32 + 8 * q4);
#pragma unroll
            for (int jt = 0; jt < 8; ++jt) {
                if (jt < 4 || second) {
                    f32x4 sacc = (f32x4){0.f, 0.f, 0.f, 0.f};
#pragma unroll
                    for (int ks = 0; ks < 2; ++ks) { const bf16x8 af = *(const LAS bf16x8*)(Ks + (jt * 16 + l15) * RP + ks * 32 + 8 * q4); sacc = __builtin_amdgcn_mfma_f32_16x16x32_bf16(af, qf[ks], sacc, 0, 0, 0); }
                    const int j0 = jt * 16 + 4 * q4; float pv[4];
#pragma unroll
                    for (int r = 0; r < 4; ++r) { const int dist = irow - (j0 + r); pv[r] = sacc[r] * __builtin_amdgcn_exp2f(lg2 * (float)(dist < 0 ? -dist : dist)); }
                    u32x2 w; w.x = pk2(pv[0], pv[1]); w.y = pk2(pv[2], pv[3]); *(LAS u32x2*)(Ps + irow * RPP + j0) = w;
                }
            }
        }
        f32x4 oacc[8];
#pragma unroll
        for (int et = 0; et < 8; ++et) oacc[et] = (f32x4){0.f, 0.f, 0.f, 0.f};
#pragma unroll
        for (int t = 0; t < 4; ++t) Sacc[t] = Sacc[t] * d128;
#pragma unroll
        for (int ks = 0; ks < (MODE < 3 ? 4 : 0); ++ks) {
            bf16x8 vf[8];
#pragma unroll
            for (int et = 0; et < 8; ++et) vf[et] = tr_frag8(Vs + ks * 32 * RPV + et * 16 + trV, RPV);
            const bf16x8 kf = tr_frag8(KPs + ks * 32 * RP + db * 16 + trK, RP);
            if (wid & 1) {
#pragma unroll
                for (int t = 0; t < 4; ++t) Sacc[t] = __builtin_amdgcn_mfma_f32_16x16x32_bf16(kf, vf[4 + t], Sacc[t], 0, 0, 0);
            } else {
#pragma unroll
                for (int t = 0; t < 4; ++t) Sacc[t] = __builtin_amdgcn_mfma_f32_16x16x32_bf16(kf, vf[t], Sacc[t], 0, 0, 0);
            }
            if (ks < 2 || second) { const bf16x8 pb = *(const LAS bf16x8*)(Ps + irow * RPP + ks * 32 + 8 * q4);
#pragma unroll
                for (int et = 0; et < 8; ++et) oacc[et] = __builtin_amdgcn_mfma_f32_16x16x32_bf16(vf[et], pb, oacc[et], 0, 0, 0); }
            if (ks < 2) {
                const u32x4 qraw = *(const LAS u32x4*)(Qs + irow * RP + ks * 32 + 8 * q4); f32x4 q0, q1; unpack8(qraw, q0, q1);
                const u32x4 qsc = pack8(q0 * qd, q1 * qd); const bf16x8 qb = __builtin_bit_cast(bf16x8, qsc);
#pragma unroll
                for (int et = 0; et < 8; ++et) { const bf16x8 sa = *(const LAS bf16x8*)(STs + (et * 16 + l15) * RP + ks * 32 + 8 * q4); oacc[et] = __builtin_amdgcn_mfma_f32_16x16x32_bf16(sa, qb, oacc[et], 0, 0, 0); } }
        }
        u32x4 gq[4];
#pragma unroll
        for (int i = 0; i < 4; ++i) { if (MODE == 0) gq[i] = *(const u32x4*)(gptr2 + (size_t)it * 128 * 1024 + (size_t)i * 4 * 1024); else gq[i] = (u32x4){0x3f803f80u, 0x3f803f80u, 0x3f803f80u, 0x3f803f80u}; }
        float s = 0.f, sq = 0.f;
#pragma unroll
        for (int et = 0; et < 8; ++et)
#pragma unroll
            for (int r = 0; r < 4; ++r) { const float o = oacc[et][r]; s += o; sq += o * o; }
        s += __shfl_xor(s, 16); sq += __shfl_xor(sq, 16); s += __shfl_xor(s, 32); sq += __shfl_xor(sq, 32);
        const float mean = s * (1.f / 128.f); const float var = sq * (1.f / 128.f) - mean * mean; const float rstd = rsqrtf(fmaxf(var, 0.f) + EPS);
#pragma unroll
        for (int et = 0; et < 8; ++et) { u32x2 w; w.x = pk2((oacc[et][0] - mean) * rstd, (oacc[et][1] - mean) * rstd); w.y = pk2((oacc[et][2] - mean) * rstd, (oacc[et][3] - mean) * rstd);
            *(LAS u32x2*)(Ps + irow * RPP + et * 16 + 4 * q4) = w; }
        __syncthreads();
#pragma unroll
        for (int t = 0; t < 4; ++t) { u32x2 w; w.x = pk2(Sacc[t][0], Sacc[t][1]); w.y = pk2(Sacc[t][2], Sacc[t][3]); *(LAS u32x2*)(STs + ((et0 + t) * 16 + l15) * RP + db * 16 + 4 * q4) = w; }
#pragma unroll
        for (int i = 0; i < 4; ++i) { const u32x4 nv = *(const LAS u32x4*)(Ps + (wid * 16 + q4 + 4 * i) * RPP + l15 * 8);
            f32x4 n0, n1, g0, g1; unpack8(nv, n0, n1); unpack8(gq[i], g0, g1);
#pragma unroll
            for (int x = 0; x < 4; ++x) { g0[x] = fsilu(g0[x]); g1[x] = fsilu(g1[x]); }
            const u32x4 w = pack8(n0 * g0, n1 * g1);
            if (MODE == 0) *(u32x4*)(optr2 + (size_t)it * 128 * 2048 + (size_t)i * 4 * 2048) = w; else asm volatile("" :: "v"(w.x), "v"(w.y), "v"(w.z), "v"(w.w)); }
    }
    __syncthreads();
}

struct ConvRegs { f32x2 w[31]; f32x2 bias; f32x4 lg[4], lb[4]; };
__device__ __forceinline__ void conv_load_regs(ConvRegs& R, const float* cw, const float* cb, const float* lng, const float* lnb, int tid) {
    const int c0 = 2 * tid, lane = tid & 63;
#pragma unroll
    for (int k = 0; k < 31; ++k) R.w[k] = *(const f32x2*)(cw + k * 1024 + c0);
    R.bias = *(const f32x2*)(cb + c0);
#pragma unroll
    for (int q = 0; q < 4; ++q) { R.lg[q] = *(const f32x4*)(lng + lane * 4 + 256 * q); R.lb[q] = *(const f32x4*)(lnb + lane * 4 + 256 * q); }
}
__device__ __forceinline__ void conv_item(const int MODE, int item, LAS unsigned char* lds, const bf16* U2, const bf16* SG2, const ConvRegs& R, bf16* V2, int tid) {
    const int b = item >> 7, l0 = (item & 127) * 32, c0 = 2 * tid;
    LAS float* T = (LAS float*)lds;
    const char* ub = (const char*)U2;
#pragma unroll 1
    for (int hf = 0; hf < 2; ++hf) {
        unsigned uraw[46]; const int lb = l0 - 30 + hf * 16;
#pragma unroll
        for (int j = 0; j < 46; ++j) { const int l = lb + j; const int lc = l < 0 ? 0 : l;
            if (MODE < 2) uraw[j] = *(const unsigned*)(ub + ((unsigned)(b * SEQ + lc) * 2048u + (unsigned)c0 * 2u)); else uraw[j] = 0x3f803f80u; }
        f32x2 u[46];
#pragma unroll
        for (int j = 0; j < 46; ++j) { const unsigned uw = (lb + j) < 0 ? 0u : uraw[j]; u[j][0] = bf2f(uw & 0xffffu); u[j][1] = bf2f(uw >> 16); }
#pragma unroll
        for (int t = 0; t < 16; ++t) { f32x2 a = R.bias;
            if (MODE < 3)
#pragma unroll
            for (int k = 0; k < 31; ++k) a += R.w[k] * u[t + k];
            *(LAS f32x2*)(T + (hf * 16 + t) * 1024 + c0) = a; }
    }
    const int wid = tid >> 6, lane = tid & 63;
    const size_t tokb = (size_t)(b * SEQ + l0 + wid * 4);
    u32x2 gt[4][4];
#pragma unroll
    for (int tt = 0; tt < 4; ++tt)
#pragma unroll
        for (int q = 0; q < 4; ++q) { if (MODE == 0) gt[tt][q] = *(const u32x2*)(SG2 + (tokb + tt) * 1024 + lane * 4 + 256 * q); else gt[tt][q] = (u32x2){0x3f803f80u, 0x3f803f80u}; }
    __syncthreads();
    f32x4 v[4][4]; float s[4], s2[4];
#pragma unroll
    for (int tt = 0; tt < 4; ++tt) { s[tt] = 0.f;
#pragma unroll
        for (int q = 0; q < 4; ++q) { v[tt][q] = *(const LAS f32x4*)(T + (wid * 4 + tt) * 1024 + lane * 4 + 256 * q); s[tt] += (v[tt][q][0] + v[tt][q][1]) + (v[tt][q][2] + v[tt][q][3]); } }
#pragma unroll
    for (int o = 1; o < 64; o <<= 1)
#pragma unroll
        for (int tt = 0; tt < 4; ++tt) s[tt] += __shfl_xor(s[tt], o);
#pragma unroll
    for (int tt = 0; tt < 4; ++tt) { const float mean = s[tt] * (1.f / 1024.f); s2[tt] = 0.f;
#pragma unroll
        for (int q = 0; q < 4; ++q) { v[tt][q] = v[tt][q] - mean; s2[tt] += (v[tt][q][0] * v[tt][q][0] + v[tt][q][1] * v[tt][q][1]) + (v[tt][q][2] * v[tt][q][2] + v[tt][q][3] * v[tt][q][3]); } }
#pragma unroll
    for (int o = 1; o < 64; o <<= 1)
#pragma unroll
        for (int tt = 0; tt < 4; ++tt) s2[tt] += __shfl_xor(s2[tt], o);
#pragma unroll
    for (int tt = 0; tt < 4; ++tt) { const float rstd = rsqrtf(s2[tt] * (1.f / 1024.f) + EPS);
#pragma unroll
        for (int q = 0; q < 4; ++q) { const u32x2 gw = gt[tt][q]; float o[4];
            const float g4[4] = {bf2f(gw.x & 0xffffu), bf2f(gw.x >> 16), bf2f(gw.y & 0xffffu), bf2f(gw.y >> 16)};
#pragma unroll
            for (int i = 0; i < 4; ++i) { const float tv = v[tt][q][i] * rstd * R.lg[q][i] + R.lb[q][i]; o[i] = tv * g4[i] * fsig2(tv, g4[i]); }
            u32x2 w; w.x = pk2(o[0], o[1]); w.y = pk2(o[2], o[3]); if (MODE == 0) *(u32x2*)(V2 + (tokb + tt) * 1024 + lane * 4 + 256 * q) = w; else asm volatile("" :: "v"(w.x), "v"(w.y)); } }
    __syncthreads();
}

typedef GAS unsigned gu32;
#define RLX_AGENT __ATOMIC_RELAXED, __HIP_MEMORY_SCOPE_AGENT
#define XB_TMO      128
#define XB_XCNT(j)  (256  + 64 * (j))
#define XB_XSUB(j)  (1280 + 64 * (j))
#define XB_XGEN(j)  (2304 + 64 * (j))
#define XB_TOP      3328
#define XB_TOPGEN   3392
#define XCD_BAR_WORDS 3456
#define XB_SPIN_CAP (1u << 18)

__device__ __forceinline__ unsigned xb_ld(unsigned* p)              { return __hip_atomic_load(p, __ATOMIC_RELAXED, __HIP_MEMORY_SCOPE_AGENT); }
__device__ __forceinline__ unsigned xb_add(unsigned* p, unsigned v) { return __hip_atomic_fetch_add(p, v, __ATOMIC_RELAXED, __HIP_MEMORY_SCOPE_AGENT); }
__device__ __forceinline__ unsigned xb_xcc_id() { return (unsigned)__builtin_amdgcn_s_getreg((3 << 11) | 20) & 0xFu; }
#define XB_SPIN(cond, bar) do { unsigned _sp = 0; while (cond) { __builtin_amdgcn_s_sleep(1); \
    if ((++_sp & 255u) == 0u) { if (xb_ld(&(bar)[XB_TMO])) break; if (_sp > XB_SPIN_CAP) { atomicAdd(&(bar)[XB_TMO], 1u); break; } } } } while (0)

struct XcdBarrier {
    unsigned* bar; unsigned x;
    volatile LAS unsigned* st;
};

__device__ __forceinline__ XcdBarrier xcd_barrier_post(unsigned* bar, volatile LAS unsigned* st) {
    XcdBarrier b; b.bar = bar; b.x = xb_xcc_id(); b.st = st;
    if (threadIdx.x == 0) (void)xb_add(&bar[XB_XCNT(b.x)], 1u);
    return b;
}
__device__ __forceinline__ void xcd_barrier_complete(unsigned* bar, unsigned x, unsigned& nloc, unsigned& nx) {
    const unsigned G = gridDim.x * gridDim.y * gridDim.z;
    unsigned sum, cnt, mine, sp = 0u;
    for (;;) {
        sum = 0u; cnt = 0u; mine = 0u;
#pragma unroll
        for (unsigned j = 0; j < 16; ++j) { const unsigned c = xb_ld(&bar[XB_XCNT(j)]); sum += c; cnt += (c > 0u) ? 1u : 0u; mine = (j == x) ? c : mine; }
        if (sum == G) break;
        __builtin_amdgcn_s_sleep(1);
        if ((++sp & 255u) == 0u) { if (xb_ld(&bar[XB_TMO])) break; if (sp > XB_SPIN_CAP) { atomicAdd(&bar[XB_TMO], 1u); break; } }
    }
    nloc = mine > 0u ? mine : 1u; nx = cnt > 0u ? cnt : 1u;
}

__device__ __forceinline__ void xcd_barrier(const XcdBarrier& b) {
    asm volatile("s_waitcnt vmcnt(0)" ::: "memory");
    __syncthreads();
    if (threadIdx.x == 0) {
        unsigned* bar = b.bar;
        __builtin_amdgcn_s_waitcnt(0);
        unsigned nloc = b.st[0], nx = b.st[1];
        if (nloc == 0u) { xcd_barrier_complete(bar, b.x, nloc, nx); b.st[0] = nloc; b.st[1] = nx; }
        const unsigned old = xb_add(&bar[XB_XSUB(b.x)], 1u);
        const unsigned gen = old / nloc;
        if (old + 1u == (gen + 1u) * nloc) {
            __builtin_amdgcn_fence(__ATOMIC_RELEASE, "agent");
            asm volatile("s_waitcnt vmcnt(0)" ::: "memory");
            const unsigned og = xb_add(&bar[XB_TOP], 1u);
            const unsigned tg = og / nx;
            if (og + 1u == (tg + 1u) * nx) xb_add(&bar[XB_TOPGEN], 1u);
            else XB_SPIN(xb_ld(&bar[XB_TOPGEN]) == tg, bar);
            __builtin_amdgcn_fence(__ATOMIC_ACQUIRE, "agent");
            xb_add(&bar[XB_XGEN(b.x)], 1u);
            asm volatile("s_waitcnt vmcnt(0)" ::: "memory");
        } else {
            XB_SPIN(xb_ld(&bar[XB_XGEN(b.x)]) == gen, bar);
            __builtin_amdgcn_fence(__ATOMIC_ACQUIRE, "agent");
            asm volatile("s_waitcnt vmcnt(0)" ::: "memory");
        }
    }
    __syncthreads();
}


#ifndef MK_PER_PHASE
#define MK_PER_PHASE 0
#endif
#ifndef PROBE_RET1_REPS
#define PROBE_RET1_REPS 1
#endif
#ifndef PROBE_RET3_REPS
#define PROBE_RET3_REPS 1
#endif
#ifndef PROBE_S5A_REPS
#define PROBE_S5A_REPS 1
#endif
#ifndef PROBE_TS_A
#define PROBE_TS_A -1
#endif
#ifndef PROBE_TS_B
#define PROBE_TS_B -1
#endif
#ifndef PROBE_P0A
#define PROBE_P0A 1
#endif
#ifndef PROBE_P0B
#define PROBE_P0B 1
#endif
#ifndef PROBE_P0C
#define PROBE_P0C 1
#endif
#ifndef PG_ALIGN_MAIN
#define PG_ALIGN_MAIN true
#endif
#ifndef PROBE_S5B_REPS
#define PROBE_S5B_REPS 1
#endif
#ifndef PROBE_RET3_MODE
#define PROBE_RET3_MODE 0
#endif
#ifndef PROBE_CONV_REPS
#define PROBE_CONV_REPS 1
#endif
#ifndef PROBE_CONV_MODE
#define PROBE_CONV_MODE 0
#endif
#ifndef PROBE_S5B2
#define PROBE_S5B2 0
#endif
#ifndef PROBE_DUP_MASK
#define PROBE_DUP_MASK 0
#endif
constexpr int N_PHASES = 8;
struct Args { const float* in[21]; float* out; unsigned char* ws; int ph_lo, ph_hi; };

__global__ void __launch_bounds__(NTHR, 2) fwd_megakernel(Args args) {
    extern __shared__ __attribute__((aligned(16))) unsigned char lds_raw[];
    LAS unsigned char* lds = (LAS unsigned char*)lds_raw;
    const int tid = threadIdx.x, lane = tid & 63, wave = __builtin_amdgcn_readfirstlane(tid >> 6);
    const int G = gridDim.x, bid = blockIdx.x;
    const int gw = bid * NWAVES + wave, NGW = G * NWAVES;
    unsigned char* ws = args.ws;
    const float* x = args.in[0]; const float* norm_g = args.in[1]; const float* final_g = args.in[2]; const float* w_in_ab = args.in[3];
    const float* s5_a_re = args.in[4]; const float* s5_a_im = args.in[5]; const float* s5_log_dt = args.in[6]; const float* s5_b_re = args.in[7]; const float* s5_b_im = args.in[8];
    const float* s5_c_re = args.in[9]; const float* s5_c_im = args.in[10]; const float* s5_d = args.in[11]; const float* s5_glu_w = args.in[12]; const float* s5_glu_b = args.in[13];
    const float* w_out_ab = args.in[14]; const float* w_in_c = args.in[15]; const float* conv_w = args.in[16]; const float* conv_b = args.in[17];
    const float* conv_ln_g = args.in[18]; const float* conv_ln_b = args.in[19]; const float* w_out_c = args.in[20];
    float* out = args.out;
    float* ss1 = (float*)(ws + WS_CTL); float* ss2 = ss1 + M;
    float* ropec = (float*)(ws + WS_ROPE); float* ropes = ropec + 4096 * 32;
    bf16* WinT = (bf16*)(ws + WS_WIN); bf16* WgluT = (bf16*)(ws + WS_WGLU); bf16* WoutT = (bf16*)(ws + WS_WOUT); bf16* WincT = (bf16*)(ws + WS_WINC); bf16* WoutcT = (bf16*)(ws + WS_WOUTC);
    bf16* Tg = (bf16*)(ws + WS_TG); bf16* Wg = (bf16*)(ws + WS_WG); float* L16 = (float*)(ws + WS_L16); float* KVseg = (float*)(ws + WS_KVSEG);
    bf16* XN = (bf16*)(ws + WS_XN); float* Sloc = (float*)(ws + WS_XN); bf16* Yg = (bf16*)(ws + WS_XN); bf16* XG2 = (bf16*)(ws + WS_XN);
    bf16* Aext = (bf16*)(ws + WS_AEXT); bf16* SG5 = (bf16*)(ws + WS_SG5); bf16* Qb = (bf16*)(ws + WS_Q); bf16* Kb = (bf16*)(ws + WS_K); bf16* Vb = (bf16*)(ws + WS_V); bf16* SGR = (bf16*)(ws + WS_SGR);
    float* X1 = (float*)(ws + WS_X1); bf16* U2 = (bf16*)(ws + WS_U2); bf16* SG2 = (bf16*)(ws + WS_SG2); bf16* V2 = (bf16*)(ws + WS_V2);
    bf16* Ymix = (bf16*)out;

    const int lo = args.ph_lo, hi = args.ph_hi;
#define IN(k) (lo <= (k) && (k) < hi)
#define SEAM(k) do { if (IN(k) && IN((k) + 1)) { if ((k) == 0) cg::this_grid().sync(); else xcd_barrier(xbar); if (PROBE_TS_A >= 0 && bid == 0 && tid == 0) tsw[(k) + 1] = __builtin_amdgcn_s_memrealtime(); } } while (0)
    unsigned long long* tsw = (unsigned long long*)(ws + WS_CTL + 786432);
    if (PROBE_TS_A >= 0 && bid == 0 && tid == 0) tsw[0] = __builtin_amdgcn_s_memrealtime();
    if (tid < 4) ((volatile LAS unsigned*)(lds + 155392))[tid] = 0u;
    __syncthreads();
    XcdBarrier xbar; xbar.bar = (unsigned*)(ws + WS_CTL + 524288); xbar.x = 0; xbar.st = (volatile LAS unsigned*)(lds + 155392);
    if (hi - lo > 1) xbar = xcd_barrier_post((unsigned*)(ws + WS_CTL + 524288), (volatile LAS unsigned*)(lds + 155392));

    if (IN(0)) {
        LAS float* scr = (LAS float*)(lds + wave * 16384);
        constexpr int I_IN = 16 * 160, I_GLU = 16 * 32, I_OUT = 32 * 32, I_INC = 16 * 96, I_OUTC = 16 * 32;
        constexpr int NITEMS = I_IN + I_GLU + I_OUT + I_INC + I_OUTC;
        for (int rep = 0; rep < PROBE_P0A; ++rep) for (int it = gw; it < NITEMS; it += NGW) {
            int r = it;
            if (r < I_IN) { p0_transpose_item(w_in_ab, 1024, 5120, WinT, 1, scr, r, lane); continue; } r -= I_IN;
            if (r < I_GLU) { p0_transpose_item(s5_glu_w, 1024, 1024, WgluT, 0, scr, r, lane); continue; } r -= I_GLU;
            if (r < I_OUT) { p0_transpose_item(w_out_ab, 2048, 1024, WoutT, 0, scr, r, lane); continue; } r -= I_OUT;
            if (r < I_INC) { p0_transpose_item(w_in_c, 1024, 3072, WincT, 2, scr, r, lane, norm_g + 1024); continue; } r -= I_INC;
            p0_transpose_item(w_out_c, 1024, 1024, WoutcT, 0, scr, r, lane);
        }
        for (int e = bid * NTHR + tid; e < 4096 * 32; e += G * NTHR) { const int pos = e >> 5, f = e & 31;
            const double freq = exp(-(double)f * (9.210340371976182736 / 32.0)); const double ang = (double)pos * freq; const double tw = 6.283185307179586476925286766559;
            const float red = (float)(ang - tw * __builtin_rint(ang / tw)); ropec[e] = cosf(red); ropes[e] = sinf(red); }
        __syncthreads();
        for (int rep = 0; rep < PROBE_P0B; ++rep) for (int it = bid; it < 256; it += G) s5_tables_item(it, (LAS float*)lds, s5_a_re, s5_a_im, s5_log_dt, s5_b_re, s5_b_im, s5_c_re, s5_c_im, s5_d, Tg, Wg, L16, tid);
        for (int rep = 0; rep < PROBE_P0C; ++rep) for (int m = gw; m < M; m += 2 * NGW) { const int m2 = m + NGW; rms_rows2_to_bf16(x + (size_t)m * DM, x + (size_t)m2 * DM, norm_g, XN + (size_t)m * DM, XN + (size_t)m2 * DM, lane); }
    }
    SEAM(0);
    if (IN(1)) {
        pg8::Gemm g{XN, WinT, 1024, 1024, 1024, 0, 0}; pg8::StaticOrder S; S.init(M, 5120, G, bid);
        EpiWin E{Aext, SG5, Qb, Kb, Vb, SGR, ropec, ropes};
        pg8::gemm_phase<EpiWin, pg8::StaticOrder, PG_ALIGN_MAIN, false>(lds, g, S, E);
    }
    SEAM(1);
#define WG_LOCAL_SEAM() do { asm volatile("s_waitcnt vmcnt(0)" ::: "memory"); __syncthreads(); __builtin_amdgcn_fence(__ATOMIC_ACQUIRE, "agent"); asm volatile("s_waitcnt vmcnt(0)" ::: "memory"); __syncthreads(); } while (0)
    if (IN(2)) {
        const int vb = (G % 8 == 0) ? (bid % 8) * (G / 8) + bid / 8 : bid;
        for (int rep = 0; rep < PROBE_S5A_REPS; ++rep) for (int it = vb; it < 512; it += G) s5_state_item(it, lds, Wg, L16, Aext, tid);
        WG_LOCAL_SEAM();
        for (int rep = 0; rep < PROBE_S5B_REPS; ++rep) { pg8::Gemm g{Aext, Tg, AEXT_LD, AEXT_LD, AEXT_LD, 0, 0}; pg8::GroupOrder S{G, vb};
          EpiYg E{Yg};
          pg8::gemm_phase<EpiYg, pg8::GroupOrder, true, false>(lds, g, S, E); }
        for (int rep = 0; rep < PROBE_RET1_REPS; ++rep) for (int it = bid; it < 256; it += G) { if ((it & 3) != 3) retention_item<false>(it, lds, Qb, Kb, Vb, SGR, KVseg, Ymix, tid); }
    }
    SEAM(2);
    if (IN(3)) {
        for (int rep = 0; rep < PROBE_RET3_REPS; ++rep) for (int it = bid; it < 256; it += G) retention_full_item(rep == 0 ? 0 : PROBE_RET3_MODE, it, lds, Qb, Kb, Vb, SGR, KVseg, Ymix, tid);
        { pg8::Gemm g{Yg, WgluT, 1024, 0, 1024, 1, M}; pg8::StaticOrder S; S.init(M, 1024, G, bid);
          EpiGlu E{Yg, SG5, s5_glu_b, Ymix};
          pg8::gemm_phase<EpiGlu, pg8::StaticOrder, PG_ALIGN_MAIN, false>(lds, g, S, E); }
    }
    SEAM(3);
    if (IN(4)) {
        pg8::Gemm g{Ymix, WoutT, 2048, 2048, 2048, 0, 0}; pg8::StaticOrder S; S.init(M, 1024, G, bid);
        EpiWout E{x, XG2, ss1};
        pg8::gemm_phase<EpiWout, pg8::StaticOrder, PG_ALIGN_MAIN, false>(lds, g, S, E);
    }
    SEAM(4);
    if (IN(5)) {
        pg8::Gemm g{XG2, WincT, 1024, 1024, 1024, 0, 0}; pg8::StaticOrder S; S.init(M, 3072, G, bid);
        EpiWinC E{ss1, U2, SG2};
        pg8::gemm_phase<EpiWinC, pg8::StaticOrder, PG_ALIGN_MAIN, false>(lds, g, S, E);
    }
    SEAM(5);
    if (IN(6)) { ConvRegs CR; conv_load_regs(CR, conv_w, conv_b, conv_ln_g, conv_ln_b, tid); for (int rep = 0; rep < PROBE_CONV_REPS; ++rep) for (int it = bid; it < 1024; it += G) conv_item(rep == 0 ? 0 : PROBE_CONV_MODE, it, lds, U2, SG2, CR, V2, tid); }
    SEAM(6);
    if (IN(7)) {
        pg8::Gemm g{V2, WoutcT, 1024, 1024, 1024, 0, 0}; pg8::StaticOrder S; S.init(M, 1024, G, bid);
        EpiWoutC E{XG2, out, final_g, ss2, (unsigned*)(ws + WS_CTL + 262144)};
        pg8::gemm_phase<EpiWoutC, pg8::StaticOrder, true, false>(lds, g, S, E);
    }
#if PROBE_S5B2
    if (IN(8)) { pg8::Gemm g{Aext, Tg, AEXT_LD, AEXT_LD, AEXT_LD, 0, 0}; pg8::GroupOrder S{G, bid}; EpiYg E{Yg}; pg8::gemm_phase<EpiYg, pg8::GroupOrder, true, false>(lds, g, S, E); }
    if (IN(9)) { pg8::Gemm g{Aext, Tg, AEXT_LD, AEXT_LD, AEXT_LD, 0, 0}; pg8::GroupOrder S{G, bid}; EpiNull E{}; pg8::gemm_phase<EpiNull, pg8::GroupOrder, true, false>(lds, g, S, E); }
#endif
    if (PROBE_TS_A >= 0) {
        xcd_barrier(xbar);
        if (bid == 0) { if (tid == 0) tsw[N_PHASES] = __builtin_amdgcn_s_memrealtime(); __syncthreads();
            const long long K = (long long)(tsw[PROBE_TS_B] - tsw[PROBE_TS_A]) * 4;
            for (long long i = tid; i < K; i += NTHR) out[i * 8 + 3] += 0.125f; }
    }
#undef IN
#undef SEAM
}

extern "C" void kernel_launch(void* const* d_in, const int* in_sizes, int n_in, void* d_out, int out_size, void* d_ws, size_t ws_size, hipStream_t stream) {
    static int grid = 0;
    if (grid == 0) {
        if (n_in != 21 || out_size != M * DM || ws_size < WS_END) { fprintf(stderr, "kernel_launch: unexpected shapes (n_in %d, out %d, ws %zu)\n", n_in, out_size, ws_size); grid = -1; return; }
        int dev = 0, cus = 0, per_cu = 0;
        if (hipGetDevice(&dev) != hipSuccess || hipDeviceGetAttribute(&cus, hipDeviceAttributeMultiprocessorCount, dev) != hipSuccess) { grid = -1; return; }
        if (hipFuncSetAttribute((const void*)fwd_megakernel, hipFuncAttributeMaxDynamicSharedMemorySize, LDS_BYTES) != hipSuccess) { fprintf(stderr, "kernel_launch: hipFuncSetAttribute failed\n"); grid = -1; return; }
        if (hipOccupancyMaxActiveBlocksPerMultiprocessor(&per_cu, (const void*)fwd_megakernel, NTHR, LDS_BYTES) != hipSuccess || per_cu < 1) { fprintf(stderr, "kernel_launch: occupancy query says %d\n", per_cu); per_cu = 1; }
        (void)hipGetLastError();
        grid = cus;
    }
    if (grid < 0) return;
    (void)hipMemsetAsync((char*)d_ws + WS_CTL, 0, CTL_ZERO_BYTES, stream);
    Args a{};
    for (int i = 0; i < 21; ++i) a.in[i] = (const float*)d_in[i];
    a.out = (float*)d_out; a.ws = (unsigned char*)d_ws;
#if MK_PER_PHASE
    for (int p = 0; p < N_PHASES; ++p) { a.ph_lo = p; a.ph_hi = p + 1; const int reps = ((PROBE_DUP_MASK >> p) & 1) ? 2 : 1;
        for (int r = 0; r < reps; ++r) hipLaunchKernelGGL(fwd_megakernel, dim3(grid), dim3(NTHR), LDS_BYTES, stream, a);
#if PROBE_S5B2
        if (p == 2) { for (int r = 0; r < 2; ++r) { a.ph_lo = 7 + PROBE_S5B2; a.ph_hi = 8 + PROBE_S5B2; hipLaunchKernelGGL(fwd_megakernel, dim3(grid), dim3(NTHR), LDS_BYTES, stream, a); } }
#endif
    }
#else
    a.ph_lo = 0; a.ph_hi = N_PHASES;
    void* kargs[] = {&a};
    hipError_t e = hipLaunchCooperativeKernel((const void*)fwd_megakernel, dim3(grid), dim3(NTHR), kargs, LDS_BYTES, stream);
    if (e != hipSuccess) fprintf(stderr, "kernel_launch: cooperative launch failed: %s (grid %d)\n", hipGetErrorString(e), grid);
#endif
}
```

```cpp
#include <hip/hip_runtime.h>
#include <hip/hip_cooperative_groups.h>
#include <cstdio>
#include <cstdint>
namespace cg = cooperative_groups;

namespace pg8 {
#define PG8_LAS __attribute__((address_space(3)))
typedef unsigned short bf16_t;
typedef short bf16x8 __attribute__((ext_vector_type(8)));
typedef float f32x4 __attribute__((ext_vector_type(4)));
typedef float f32x2 __attribute__((ext_vector_type(2)));
typedef unsigned u32x4 __attribute__((ext_vector_type(4)));
typedef unsigned u32x2 __attribute__((ext_vector_type(2)));
constexpr int BM = 256, BK = 64, HALF = 128, HTB = HALF * BK * 2  , STAGE_BYTES = 8 * HTB, NXCD = 8, WGM = 8;

__host__ __device__ __forceinline__ int lds_byte(int r, int c) { const int st = (r >> 4) * 2 + (c >> 5), rr = r & 15, cc = c & 31, ob = rr * 64 + cc * 2; return st * 1024 + (ob ^ (((ob >> 9) & 1) << 5)); }
__host__ __device__ __forceinline__ void stage_rc(int b, int& R, int& C) { const int st = b / 1024, sb = b % 1024, swz = sb ^ (((sb >> 9) & 1) << 5); R = (st >> 1) * 16 + swz / 64; C = (st & 1) * 32 + (swz % 64) / 2; }
__host__ __device__ __forceinline__ int perm32(int rho) { const int n = rho >> 4, i = rho & 15; return 8 * (i >> 2) + 4 * n + (i & 3); }

struct Unit { int pm, pn; };
struct Gemm { const bf16_t* A; const bf16_t* Bt; int K, lda, ldb, amode, gM; unsigned gstride, agap; };

struct StaticOrder {
    int nM, nN, nwg, G, c;
    __host__ __device__ void init(int M, int N, int G_, int c_) { nM = M / BM; nN = N / BM; nwg = nM * nN; G = G_; c = c_; }
    __host__ __device__ bool next(int i, Unit& u) const {
        const long L = (long)i * G + c; if (L >= nwg) return false;
        int wgid = (int)L; { const int q = nwg / NXCD, r = nwg % NXCD, xcd = wgid % NXCD, off = wgid / NXCD; wgid = (xcd < r ? xcd * (q + 1) : r * (q + 1) + (xcd - r) * q) + off; }
        const int nig = WGM * nN, gid = wgid / nig, fm = gid * WGM, gsz = (nM - fm) < WGM ? (nM - fm) : WGM;
        u.pm = fm + ((wgid % nig) % gsz); u.pn = (wgid % nig) / gsz; return true;
    }
};
struct GroupOrder {
    int G, c;
    __host__ __device__ bool next(int i, Unit& u) const { const int L = i * G + c; if (L >= 512) return false; u.pm = L; u.pn = L >> 3; return true; }
};

__device__ __forceinline__ unsigned cvt_pk_bf16(float lo, float hi) { unsigned r; asm volatile("v_cvt_pk_bf16_f32 %0, %1, %2" : "=v"(r) : "v"(lo), "v"(hi)); return r; }

template <class Epi, class Sched, bool ALIGN_EPI, bool SKIPB1, bool ZSKIP = false>
__device__ __forceinline__ void gemm_phase(PG8_LAS unsigned char* lds, const Gemm g, const Sched& S, const Epi& E) {
    const int tid = threadIdx.x, wid = __builtin_amdgcn_readfirstlane(tid >> 6), lane = tid & 63, wr = wid >> 2, wc = wid & 3, fr = lane & 15, fq = lane >> 4;
    const int K = g.K, nt = K / BK;
    unsigned voffA[2], voffB[2];
#pragma unroll
    for (int i = 0; i < 2; ++i) { int R, C; stage_rc(tid * 16 + i * 8192, R, C); const int Rb = Epi::PERM ? ((R & ~31) + perm32(R & 31)) : R;
        voffA[i] = g.amode ? (unsigned)(C >> 4) * g.gstride + (unsigned)(R * 32 + (C & 15) * 2) : (unsigned)(R * g.lda + C) * 2u;
        voffB[i] = (unsigned)(Rb * g.ldb + C) * 2u; }
    const size_t kstepA = g.amode ? (size_t)g.gstride * 4 : (size_t)(BK * 2);
    const size_t kstepB = (size_t)(BK * 2);
    const size_t hstepA = g.amode ? (size_t)HALF * 32 : (size_t)HALF * g.lda * 2;
    const size_t hstepB = (size_t)HALF * g.ldb * 2;
    const size_t tstepA = 2 * hstepA, tstepB = 2 * hstepB;
    const unsigned ldsw = (unsigned)wid * 1024u;
    const int aoff = lds_byte(wr * 64 + fr, fq * 8), boff = lds_byte(wc * 32 + fr, fq * 8);
#define PG8_SA(b, h) (((b) * 2 + (h)) * HTB)
#define PG8_SB(b, h) ((4 + (b) * 2 + (h)) * HTB)
#define PG8_STAGE(bufoff, gbase, voff) do { _Pragma("unroll") for (int _i = 0; _i < 2; ++_i) \
        __builtin_amdgcn_global_load_lds((const unsigned*)((const char*)(gbase) + (voff)[_i]), (PG8_LAS unsigned*)(lds + (bufoff) + ldsw + _i * 8192), 16, 0, 0); } while (0)
#define PG8_LDA(dst, b, h) do { _Pragma("unroll") for (int m = 0; m < 4; ++m) _Pragma("unroll") for (int k = 0; k < 2; ++k) dst[m][k] = *(const PG8_LAS bf16x8*)(lds + PG8_SA(b, h) + aoff + m * 2048 + k * 1024); } while (0)
#define PG8_LDB(dst, b, h) do { _Pragma("unroll") for (int n = 0; n < 2; ++n) _Pragma("unroll") for (int k = 0; k < 2; ++k) dst[n][k] = *(const PG8_LAS bf16x8*)(lds + PG8_SB(b, h) + boff + n * 2048 + k * 1024); } while (0)
#define PG8_MMA(ai, bj, At, Bt) do { __builtin_amdgcn_s_setprio(1); _Pragma("unroll") for (int m = 0; m < 4; ++m) _Pragma("unroll") for (int n = 0; n < 2; ++n) _Pragma("unroll") for (int k = 0; k < 2; ++k) \
        acc[ai][bj][m][n] = __builtin_amdgcn_mfma_f32_16x16x32_bf16(Bt[n][k], At[m][k], acc[ai][bj][m][n], 0, 0, 0); __builtin_amdgcn_s_setprio(0); } while (0)
#define PG8_MMA1(ai, At, Bt) do { if constexpr (!SKIPB1) PG8_MMA(ai, 1, At, Bt); } while (0)
#define PG8_MMA0(ai, At, Bt) do { if (!(ZSKIP && t == 2)) PG8_MMA(ai, 0, At, Bt); } while (0)
#define PG8_WAIT_V(n) asm volatile("s_waitcnt vmcnt(" #n ")" ::: "memory")
#define PG8_WAIT_L(n) asm volatile("s_waitcnt lgkmcnt(" #n ")" ::: "memory")
#define PG8_BAR __builtin_amdgcn_s_barrier()
#define PG8_SCHED __builtin_amdgcn_sched_barrier(0)
    Unit cur, nxt; int ui = 0;
    if (!S.next(0, cur)) return;
    f32x4 acc[2][2][4][2];
#pragma unroll
    for (int a = 0; a < 2; ++a)
#pragma unroll
        for (int b = 0; b < 2; ++b)
#pragma unroll
            for (int m = 0; m < 4; ++m)
#pragma unroll
                for (int n = 0; n < 2; ++n) acc[a][b][m][n] = (f32x4){0.f, 0.f, 0.f, 0.f};
    bf16x8 At[4][2], B0[2][2], B1[2][2];
    const char* cA = (const char*)g.A + (size_t)cur.pm * tstepA + (size_t)(cur.pm >> 4) * g.agap; const char* cB = (const char*)g.Bt + (size_t)cur.pn * tstepB;
    PG8_STAGE(PG8_SB(0, 0), cB, voffB); PG8_STAGE(PG8_SB(0, 1), cB + hstepB, voffB); PG8_STAGE(PG8_SA(0, 0), cA, voffA); PG8_STAGE(PG8_SA(0, 1), cA + hstepA, voffA);
    if (wr == 1) PG8_BAR;
    PG8_WAIT_V(2); PG8_BAR;
    PG8_STAGE(PG8_SB(1, 0), cB + kstepB, voffB); PG8_STAGE(PG8_SA(1, 0), cA + kstepA, voffA); PG8_STAGE(PG8_SB(1, 1), cB + hstepB + kstepB, voffB);
    PG8_WAIT_V(6); PG8_BAR;
    for (;;) {
        const bool has_next = S.next(ui + 1, nxt);
        const char* nA = has_next ? (const char*)g.A + (size_t)nxt.pm * tstepA + (size_t)(nxt.pm >> 4) * g.agap : cA; const char* nB = has_next ? (const char*)g.Bt + (size_t)nxt.pn * tstepB : cB;
        for (int t = 0; t < nt; t += 2) {
            const bool last = (t == nt - 2);
            const char* a1 = cA + (size_t)(t + 1) * kstepA;
            const char* a2 = last ? nA : cA + (size_t)(t + 2) * kstepA; const char* b2 = last ? nB : cB + (size_t)(t + 2) * kstepB;
            const char* a3 = a2 + kstepA; const char* b3 = b2 + kstepB;
            PG8_LDB(B0, 0, 0); PG8_LDB(B1, 0, 1); PG8_SCHED; PG8_LDA(At, 0, 0); PG8_STAGE(PG8_SA(1, 1), a1 + hstepA, voffA);
            PG8_WAIT_V(8); PG8_WAIT_L(0); PG8_BAR; PG8_MMA0(0, At, B0); PG8_MMA1(0, At, B1); PG8_BAR; PG8_SCHED;
            PG8_LDA(At, 0, 1); PG8_STAGE(PG8_SB(0, 0), b2, voffB); PG8_STAGE(PG8_SB(0, 1), b2 + hstepB, voffB); PG8_STAGE(PG8_SA(0, 0), a2, voffA);
            PG8_WAIT_V(8); PG8_WAIT_L(0); PG8_BAR; PG8_MMA0(1, At, B0); PG8_MMA1(1, At, B1); PG8_BAR; PG8_SCHED;
            PG8_LDB(B0, 1, 0); PG8_LDB(B1, 1, 1); PG8_SCHED; PG8_LDA(At, 1, 0); PG8_STAGE(PG8_SA(0, 1), a2 + hstepA, voffA);
            PG8_WAIT_V(8); PG8_WAIT_L(0); PG8_BAR; PG8_MMA0(0, At, B0); PG8_MMA1(0, At, B1); PG8_BAR; PG8_SCHED;
            PG8_LDA(At, 1, 1); PG8_STAGE(PG8_SB(1, 0), b3, voffB); PG8_STAGE(PG8_SB(1, 1), b3 + hstepB, voffB); PG8_STAGE(PG8_SA(1, 0), a3, voffA);
            PG8_WAIT_V(8); PG8_WAIT_L(0); PG8_BAR; PG8_MMA0(1, At, B0); PG8_MMA1(1, At, B1); PG8_BAR; PG8_SCHED;
        }
        if constexpr (ALIGN_EPI) { if (wr == 0) PG8_BAR; }
        E(acc, cur, wr, wc, fr, fq);
        if (!has_next) break;
#pragma unroll
        for (int a = 0; a < 2; ++a)
#pragma unroll
            for (int b = 0; b < 2; ++b)
#pragma unroll
                for (int m = 0; m < 4; ++m)
#pragma unroll
                    for (int n = 0; n < 2; ++n) acc[a][b][m][n] = (f32x4){0.f, 0.f, 0.f, 0.f};
        cur = nxt; cA = nA; cB = nB; ++ui;
        if constexpr (ALIGN_EPI) { if (wr == 1) PG8_BAR; }
    }
    PG8_WAIT_V(0);
    if constexpr (!ALIGN_EPI) { if (wr == 0) PG8_BAR; }
    PG8_BAR;
#undef PG8_SA
#undef PG8_SB
#undef PG8_STAGE
#undef PG8_LDA
#undef PG8_LDB
#undef PG8_MMA
#undef PG8_MMA1
#undef PG8_MMA0
#undef PG8_WAIT_V
#undef PG8_WAIT_L
#undef PG8_BAR
#undef PG8_SCHED
}
}

#define GAS __attribute__((address_space(1)))
#define LAS __attribute__((address_space(3)))
typedef unsigned short bf16;
typedef pg8::f32x4 f32x4;
typedef pg8::f32x2 f32x2;
typedef pg8::u32x4 u32x4;
typedef pg8::u32x2 u32x2;
typedef pg8::bf16x8 bf16x8;
constexpr int NWAVES = 8, NTHR = 512;
constexpr int M = 32768, DM = 1024, SEQ = 4096;
constexpr float EPS = 1e-6f;
constexpr size_t MiB = 1u << 20;
constexpr size_t WS_CTL = 0, CTL_ZERO_BYTES = 1 * MiB;
constexpr size_t WS_ROPE = 1 * MiB;
constexpr size_t WS_WIN = 2 * MiB, WS_WGLU = 12 * MiB, WS_WOUT = 14 * MiB, WS_WINC = 18 * MiB, WS_WOUTC = 24 * MiB;
constexpr size_t WS_TG = 26 * MiB, WS_WG = 38 * MiB, WS_L16 = 46 * MiB, WS_KVSEG = 48 * MiB;
constexpr size_t WS_XN = 64 * MiB;
constexpr size_t WS_AEXT = 128 * MiB;
constexpr size_t WS_SG5 = 224 * MiB, WS_Q = 288 * MiB, WS_K = 320 * MiB, WS_V = 352 * MiB, WS_SGR = 416 * MiB;
constexpr size_t WS_X1 = 128 * MiB, WS_U2 = 256 * MiB, WS_SG2 = 320 * MiB, WS_V2 = 384 * MiB, WS_END = 480 * MiB;
constexpr int LDS_BYTES = 155648;
constexpr int AEXT_LD = 384;

__device__ __forceinline__ float fsigmoid(float x) { return __builtin_amdgcn_rcpf(1.0f + __expf(-x)); }
__device__ __forceinline__ float fsilu(float x) { return x * fsigmoid(x); }
__device__ __forceinline__ float fsig2(float a, float b) { return __builtin_amdgcn_rcpf((1.0f + __expf(-a)) * (1.0f + __expf(-b))); }
__device__ __forceinline__ float fgelu_tanh(float x) { const float u = 1.5957691216f * (x + 0.044715f * x * x * x); return x * fsigmoid(u); }
__device__ __forceinline__ unsigned f2bf(float f) { unsigned u = __builtin_bit_cast(unsigned, f); return (u + 0x7fffu + ((u >> 16) & 1u)) >> 16; }
__device__ __forceinline__ float bf2f(unsigned h) { return __builtin_bit_cast(float, h << 16); }
__device__ __forceinline__ unsigned pk2(float lo, float hi) { return pg8::cvt_pk_bf16(lo, hi); }
__device__ __forceinline__ u32x4 pack8(f32x4 a, f32x4 b) { u32x4 w; w.x = pk2(a[0], a[1]); w.y = pk2(a[2], a[3]); w.z = pk2(b[0], b[1]); w.w = pk2(b[2], b[3]); return w; }
__device__ __forceinline__ void unpack8(u32x4 w, f32x4& a, f32x4& b) {
    a[0] = bf2f(w.x & 0xffffu); a[1] = bf2f(w.x >> 16); a[2] = bf2f(w.y & 0xffffu); a[3] = bf2f(w.y >> 16);
    b[0] = bf2f(w.z & 0xffffu); b[1] = bf2f(w.z >> 16); b[2] = bf2f(w.w & 0xffffu); b[3] = bf2f(w.w >> 16); }
__device__ __forceinline__ float wave_sum(float v) {
#pragma unroll
    for (int o = 1; o < 64; o <<= 1) v += __shfl_xor(v, o);
    return v;
}

typedef f32x4 AccT[2][2][4][2];

struct EpiWin {
    static constexpr bool PERM = true;
    bf16 *Aext, *SG5, *Q, *Kb, *V, *SGR; const float *ropec, *ropes;
    __device__ __forceinline__ void operator()(const AccT& acc, const pg8::Unit& u, int wr, int wc, int fr, int fq) const {
        const int pn = u.pn, row0 = u.pm * 256 + wr * 64 + fr;
        const bool rope = pn >= 8 && pn < 12; const int jr = 4 * (wc & 1) + fq;
#pragma unroll
        for (int ai = 0; ai < 2; ++ai) {
            f32x4 csv[4], snv[4];
            if (rope) {
#pragma unroll
                for (int m = 0; m < 4; ++m) { const int pos = (row0 + ai * 128 + m * 16) & (SEQ - 1); csv[m] = *(const f32x4*)(ropec + pos * 32 + 4 * jr); snv[m] = *(const f32x4*)(ropes + pos * 32 + 4 * jr); }
            }
#pragma unroll
            for (int m = 0; m < 4; ++m) { const int row = row0 + ai * 128 + m * 16;
#pragma unroll
                for (int bj = 0; bj < 2; ++bj) { const int colt = pn * 256 + bj * 128 + wc * 32 + 8 * fq;
                    f32x4 v0 = acc[ai][bj][m][0], v1 = acc[ai][bj][m][1];
                    if (pn < 4) {
                        const int g = colt >> 4, h0 = colt & 15;
                        bf16* dst = Aext + (size_t)g * (2048 * AEXT_LD) + (size_t)(row >> 4) * AEXT_LD + (row & 15) * 16 + h0;
                        *(u32x4*)dst = pack8(v0, v1);
                    } else if (pn < 8) {
                        *(u32x4*)(SG5 + (size_t)row * 1024 + (colt - 1024)) = pack8(v0, v1);
                    } else if (pn < 12) {
                        const bool isq = pn < 10; const int c = colt - (isq ? 2048 : 2560);
                        const f32x4 cs = csv[m], sn = snv[m];
                        const float sc = isq ? 0.125f : 1.0f;
                        f32x4 o1 = (v0 * cs - v1 * sn) * sc, o2 = (v0 * sn + v1 * cs) * sc;
                        *(u32x4*)((isq ? Q : Kb) + (size_t)row * 512 + c) = pack8(o1, o2);
                    } else if (pn < 16) {
                        *(u32x4*)(V + (size_t)row * 1024 + (colt - 3072)) = pack8(v0, v1);
                    } else {
                        *(u32x4*)(SGR + (size_t)row * 1024 + (colt - 4096)) = pack8(v0, v1);
                    } } } }
    }
};
struct EpiSloc {
    static constexpr bool PERM = false;
    float* O;
    __device__ __forceinline__ void operator()(const AccT& acc, const pg8::Unit& u, int wr, int wc, int fr, int fq) const {
        const int row0 = u.pm * 256 + wr * 64 + fr, col0 = wc * 32 + 4 * fq;
#pragma unroll
        for (int ai = 0; ai < 2; ++ai)
#pragma unroll
            for (int m = 0; m < 4; ++m) { float* rowp = O + (size_t)(row0 + ai * 128 + m * 16) * 128 + col0;
#pragma unroll
                for (int n = 0; n < 2; ++n) *(f32x4*)(rowp + 16 * n) = acc[ai][0][m][n]; }
    }
};
constexpr int YG_PANEL = 98304;
constexpr int YG_GROUP = 8 * YG_PANEL;
struct EpiYg {
    static constexpr bool PERM = true;
    bf16* O;
    __device__ __forceinline__ void operator()(const AccT& acc, const pg8::Unit& u, int wr, int wc, int fr, int fq) const {
        const unsigned idx0 = (unsigned)u.pm * (unsigned)YG_PANEL + (unsigned)((wr * 64 + fr) * 256 + wc * 32 + 8 * fq);
#pragma unroll
        for (int ai = 0; ai < 2; ++ai)
#pragma unroll
            for (int m = 0; m < 4; ++m) { bf16* rowp = O + (idx0 + (unsigned)((ai * 128 + m * 16) * 256));
#pragma unroll
                for (int bj = 0; bj < 2; ++bj) { f32x4 v0 = acc[ai][bj][m][0], v1 = acc[ai][bj][m][1];
#pragma unroll
                    for (int i = 0; i < 4; ++i) { v0[i] = fgelu_tanh(v0[i]); v1[i] = fgelu_tanh(v1[i]); }
                    *(u32x4*)(rowp + bj * 128) = pack8(v0, v1); } }
    }
};
struct EpiNull {
    static constexpr bool PERM = true;
    __device__ __forceinline__ void operator()(const AccT& acc, const pg8::Unit&, int, int, int, int) const {
#pragma unroll
        for (int a = 0; a < 2; ++a)
#pragma unroll
            for (int b = 0; b < 2; ++b)
#pragma unroll
                for (int m = 0; m < 4; ++m)
#pragma unroll
                    for (int n = 0; n < 2; ++n) asm volatile("" :: "v"(acc[a][b][m][n]));
    }
};
struct EpiGlu {
    static constexpr bool PERM = true;
    const bf16* Yg; const bf16* SG5; const float* bias; bf16* Ymix;
    __device__ __forceinline__ void operator()(const AccT& acc, const pg8::Unit& u, int wr, int wc, int fr, int fq) const {
        const int row0 = u.pm * 256 + wr * 64 + fr, colb = u.pn * 256 + wc * 32 + 8 * fq;
        f32x4 bv[2][2];
#pragma unroll
        for (int bj = 0; bj < 2; ++bj)
#pragma unroll
            for (int n = 0; n < 2; ++n) bv[bj][n] = *(const f32x4*)(bias + colb + bj * 128 + 4 * n);
#pragma unroll
        for (int ai = 0; ai < 2; ++ai) {
            u32x4 yw[4][2], gw[4][2];
#pragma unroll
            for (int m = 0; m < 4; ++m) { const int row = row0 + ai * 128 + m * 16;
#pragma unroll
                for (int bj = 0; bj < 2; ++bj) { const int c = colb + bj * 128;
                    yw[m][bj] = *(const u32x4*)(Yg + (size_t)(c >> 4) * YG_GROUP + (size_t)(row >> 12) * YG_PANEL + (size_t)(row & 4095) * 16 + (c & 15));
                    gw[m][bj] = *(const u32x4*)(SG5 + (size_t)row * 1024 + c); } }
#pragma unroll
            for (int m = 0; m < 4; ++m) { const int row = row0 + ai * 128 + m * 16;
#pragma unroll
                for (int bj = 0; bj < 2; ++bj) { const int c = colb + bj * 128;
                    f32x4 y0, y1, g0, g1; unpack8(yw[m][bj], y0, y1); unpack8(gw[m][bj], g0, g1);
                    f32x4 z0 = acc[ai][bj][m][0] + bv[bj][0], z1 = acc[ai][bj][m][1] + bv[bj][1];
#pragma unroll
                    for (int i = 0; i < 4; ++i) { z0[i] = y0[i] * g0[i] * fsig2(z0[i], g0[i]); z1[i] = y1[i] * g1[i] * fsig2(z1[i], g1[i]); }
                    *(u32x4*)(Ymix + (size_t)row * 2048 + c) = pack8(z0, z1); } }
            asm volatile("" ::: "memory"); }
    }
};
struct EpiWout {
    static constexpr bool PERM = true;
    bf16* XB; const float* rinv; float* ss1;
    __device__ __forceinline__ void operator()(const AccT& acc, const pg8::Unit& u, int wr, int wc, int fr, int fq) const {
        const int row0 = u.pm * 256 + wr * 64 + fr, colb = u.pn * 256 + wc * 32 + 8 * fq;
#pragma unroll
        for (int ai = 0; ai < 2; ++ai) {
            float ri[4];
#pragma unroll
            for (int m = 0; m < 4; ++m) ri[m] = rinv[row0 + ai * 128 + m * 16];
            u32x4 xw[4][2];
#pragma unroll
            for (int m = 0; m < 4; ++m) { const size_t off = (size_t)(row0 + ai * 128 + m * 16) * 1024 + colb;
#pragma unroll
                for (int bj = 0; bj < 2; ++bj) xw[m][bj] = *(const u32x4*)(XB + off + bj * 128); }
#pragma unroll
            for (int m = 0; m < 4; ++m) { const int row = row0 + ai * 128 + m * 16; const size_t off = (size_t)row * 1024 + colb; float s = 0.f;
#pragma unroll
                for (int bj = 0; bj < 2; ++bj) { f32x4 x1[2]; unpack8(xw[m][bj], x1[0], x1[1]);
#pragma unroll
                    for (int n = 0; n < 2; ++n) { x1[n] = x1[n] * ri[m] + acc[ai][bj][m][n];
                        s += (x1[n][0] * x1[n][0] + x1[n][1] * x1[n][1]) + (x1[n][2] * x1[n][2] + x1[n][3] * x1[n][3]); }
                    *(u32x4*)(XB + off + bj * 128) = pack8(x1[0], x1[1]); }
                s += __shfl_xor(s, 16); s += __shfl_xor(s, 32);
                if (fq == 0) atomicAdd(ss1 + row, s); }
            asm volatile("" ::: "memory"); }
    }
};
struct EpiWinC {
    static constexpr bool PERM = true;
    const float* ss1; bf16* U2; bf16* SG2;
    __device__ __forceinline__ void operator()(const AccT& acc, const pg8::Unit& u, int wr, int wc, int fr, int fq) const {
        const int pn = u.pn, row0 = u.pm * 256 + wr * 64 + fr;
        float rs[2][4];
#pragma unroll
        for (int ai = 0; ai < 2; ++ai)
#pragma unroll
            for (int m = 0; m < 4; ++m) rs[ai][m] = ss1[row0 + ai * 128 + m * 16];
#pragma unroll
        for (int ai = 0; ai < 2; ++ai)
#pragma unroll
            for (int m = 0; m < 4; ++m) { const int row = row0 + ai * 128 + m * 16; const float r = rsqrtf(rs[ai][m] * (1.0f / 1024.0f) + EPS);
                if (pn < 8) {
                    f32x4 a0 = acc[ai][0][m][0] * r, a1 = acc[ai][0][m][1] * r, b0 = acc[ai][1][m][0] * r, b1 = acc[ai][1][m][1] * r;
#pragma unroll
                    for (int i = 0; i < 4; ++i) { a0[i] *= fsigmoid(b0[i]); a1[i] *= fsigmoid(b1[i]); }
                    *(u32x4*)(U2 + (size_t)row * 1024 + pn * 128 + wc * 32 + 8 * fq) = pack8(a0, a1);
                } else {
#pragma unroll
                    for (int bj = 0; bj < 2; ++bj) { f32x4 v0 = acc[ai][bj][m][0] * r, v1 = acc[ai][bj][m][1] * r;
                        *(u32x4*)(SG2 + (size_t)row * 1024 + (pn - 8) * 256 + bj * 128 + wc * 32 + 8 * fq) = pack8(v0, v1); }
                } }
    }
};
struct EpiWoutC {
    static constexpr bool PERM = true;
    const bf16* X1B; float* O; const float* fg; float* ss2; unsigned* cnt;
    __device__ __forceinline__ void operator()(AccT& acc, const pg8::Unit& u, int wr, int wc, int fr, int fq) const {
        const int row0 = u.pm * 256 + wr * 64 + fr, colb = u.pn * 256 + wc * 32 + 8 * fq;
#pragma unroll
        for (int ai = 0; ai < 2; ++ai) {
            u32x4 xw[4][2];
#pragma unroll
            for (int m = 0; m < 4; ++m) { const size_t off = (size_t)(row0 + ai * 128 + m * 16) * 1024 + colb;
#pragma unroll
                for (int bj = 0; bj < 2; ++bj) xw[m][bj] = *(const u32x4*)(X1B + off + bj * 128); }
#pragma unroll
            for (int m = 0; m < 4; ++m) { const int row = row0 + ai * 128 + m * 16; float s = 0.f;
#pragma unroll
                for (int bj = 0; bj < 2; ++bj) { f32x4 xv2[2]; unpack8(xw[m][bj], xv2[0], xv2[1]);
#pragma unroll
                    for (int n = 0; n < 2; ++n) { const f32x4 x2 = xv2[n] + acc[ai][bj][m][n]; acc[ai][bj][m][n] = x2;
                        s += (x2[0] * x2[0] + x2[1] * x2[1]) + (x2[2] * x2[2] + x2[3] * x2[3]); } }
                s += __shfl_xor(s, 16); s += __shfl_xor(s, 32);
                if (fq == 0) atomicAdd(ss2 + row, s); }
            asm volatile("" ::: "memory"); }
        asm volatile("s_waitcnt vmcnt(0)" ::: "memory");
        unsigned* c = cnt + 64 * u.pm;
        if ((threadIdx.x & 63) == 0) __hip_atomic_fetch_add(c, 1u, __ATOMIC_RELAXED, __HIP_MEMORY_SCOPE_AGENT);
        { unsigned sp = 0; while (__hip_atomic_load(c, __ATOMIC_RELAXED, __HIP_MEMORY_SCOPE_AGENT) < 32u) { __builtin_amdgcn_s_sleep(2); if (++sp > (1u << 22)) break; } }
        __builtin_amdgcn_fence(__ATOMIC_ACQUIRE, "agent");
        f32x4 gv[2][2];
#pragma unroll
        for (int bj = 0; bj < 2; ++bj)
#pragma unroll
            for (int n = 0; n < 2; ++n) gv[bj][n] = *(const f32x4*)(fg + colb + bj * 128 + 4 * n);
#pragma unroll
        for (int ai = 0; ai < 2; ++ai)
#pragma unroll
            for (int m = 0; m < 4; ++m) { const int row = row0 + ai * 128 + m * 16; const size_t off = (size_t)row * 1024 + colb;
                const float r = rsqrtf(__hip_atomic_load(ss2 + row, __ATOMIC_RELAXED, __HIP_MEMORY_SCOPE_AGENT) * (1.0f / 1024.0f) + EPS);
#pragma unroll
                for (int bj = 0; bj < 2; ++bj)
#pragma unroll
                    for (int n = 0; n < 2; ++n) *(f32x4*)(O + off + bj * 128 + 4 * n) = acc[ai][bj][m][n] * r * gv[bj][n]; }
    }
};

#define LDS_WAIT() asm volatile("s_waitcnt lgkmcnt(0)" ::: "memory")
__device__ __forceinline__ int dest_row(int n, int mode) {
    if (mode == 1) { if (n >= 2048 && n < 3072) { const int d = n & 63; return (n & ~63) + 8 * ((d & 31) >> 2) + 4 * (d >> 5) + (d & 3); } return n; }
    if (mode == 2) { if (n < 1024) return 256 * (n >> 7) + (n & 127); if (n < 2048) { const int q = n - 1024; return 256 * (q >> 7) + 128 + (q & 127); } return n; }
    return n;
}
__device__ __forceinline__ void p0_transpose_item(const float* W, int K, int N, bf16* WT, int mode, LAS float* scr, int item, int lane, const float* kscale = nullptr) {
    const int nblk = N / 32, kb = item / nblk, nb = item % nblk, k0 = 64 * kb, n0 = 32 * nb;
    float wv[32];
#pragma unroll
    for (int i = 0; i < 32; ++i) wv[i] = W[(size_t)(k0 + 2 * i + (lane >> 5)) * N + n0 + (lane & 31)];
    if (kscale) {
#pragma unroll
        for (int i = 0; i < 32; ++i) wv[i] *= kscale[k0 + 2 * i + (lane >> 5)]; }
#pragma unroll
    for (int i = 0; i < 32; ++i) scr[(2 * i + (lane >> 5)) * 33 + (lane & 31)] = wv[i];
    LDS_WAIT(); asm volatile("" ::: "memory");
    const int c = lane & 7;
#pragma unroll
    for (int j = 0; j < 4; ++j) { const int n = (lane >> 3) + 8 * j; const LAS float* s = scr + (8 * c) * 33 + n;
        u32x4 o; o.x = pk2(s[0 * 33], s[1 * 33]); o.y = pk2(s[2 * 33], s[3 * 33]); o.z = pk2(s[4 * 33], s[5 * 33]); o.w = pk2(s[6 * 33], s[7 * 33]);
        *(u32x4*)(WT + (size_t)dest_row(n0 + n, mode) * K + k0 + 8 * c) = o; }
    LDS_WAIT(); asm volatile("" ::: "memory");
}
__device__ __forceinline__ void rms_row_to_bf16(const float* xrow, const float* g, bf16* orow, int lane) {
    const f32x4* xr = (const f32x4*)xrow + lane; const f32x4* gr = (const f32x4*)g + lane;
    f32x4 v[4]; float s = 0.f;
#pragma unroll
    for (int j = 0; j < 4; ++j) { v[j] = xr[64 * j]; s += (v[j][0] * v[j][0] + v[j][1] * v[j][1]) + (v[j][2] * v[j][2] + v[j][3] * v[j][3]); }
    const float r = rsqrtf(wave_sum(s) * (1.f / 1024.f) + EPS);
    u32x2* o8 = (u32x2*)orow + lane;
#pragma unroll
    for (int j = 0; j < 4; ++j) { const f32x4 gg = gr[64 * j]; u32x2 w; w.x = pk2(v[j][0] * r * gg[0], v[j][1] * r * gg[1]); w.y = pk2(v[j][2] * r * gg[2], v[j][3] * r * gg[3]); o8[64 * j] = w; }
}
__device__ __forceinline__ void rms_rows2_to_bf16(const float* x0, const float* x1, const float* g, bf16* o0, bf16* o1, int lane) {
    const f32x4* xa = (const f32x4*)x0 + lane; const f32x4* xb = (const f32x4*)x1 + lane; const f32x4* gr = (const f32x4*)g + lane;
    f32x4 va[4], vb[4]; float sa = 0.f, sb = 0.f;
#pragma unroll
    for (int j = 0; j < 4; ++j) { va[j] = xa[64 * j]; vb[j] = xb[64 * j]; }
#pragma unroll
    for (int j = 0; j < 4; ++j) { sa += (va[j][0] * va[j][0] + va[j][1] * va[j][1]) + (va[j][2] * va[j][2] + va[j][3] * va[j][3]); sb += (vb[j][0] * vb[j][0] + vb[j][1] * vb[j][1]) + (vb[j][2] * vb[j][2] + vb[j][3] * vb[j][3]); }
#pragma unroll
    for (int o = 1; o < 64; o <<= 1) { sa += __shfl_xor(sa, o); sb += __shfl_xor(sb, o); }
    const float ra = rsqrtf(sa * (1.f / 1024.f) + EPS), rb = rsqrtf(sb * (1.f / 1024.f) + EPS);
    u32x2* pa = (u32x2*)o0 + lane; u32x2* pb = (u32x2*)o1 + lane;
#pragma unroll
    for (int j = 0; j < 4; ++j) { const f32x4 gg = gr[64 * j]; u32x2 w;
        w.x = pk2(va[j][0] * ra * gg[0], va[j][1] * ra * gg[1]); w.y = pk2(va[j][2] * ra * gg[2], va[j][3] * ra * gg[3]); pa[64 * j] = w;
        w.x = pk2(vb[j][0] * rb * gg[0], vb[j][1] * rb * gg[1]); w.y = pk2(vb[j][2] * rb * gg[2], vb[j][3] * rb * gg[3]); pb[64 * j] = w; }
}
__device__ __forceinline__ void rms_rows2_plain(const float* x0, const float* x1, bf16* o0, bf16* o1, float* ri0, float* ri1, int lane) {
    const f32x4* xa = (const f32x4*)x0 + lane; const f32x4* xb = (const f32x4*)x1 + lane;
    f32x4 va[4], vb[4]; float sa = 0.f, sb = 0.f;
#pragma unroll
    for (int j = 0; j < 4; ++j) { va[j] = xa[64 * j]; vb[j] = xb[64 * j]; }
#pragma unroll
    for (int j = 0; j < 4; ++j) { sa += (va[j][0] * va[j][0] + va[j][1] * va[j][1]) + (va[j][2] * va[j][2] + va[j][3] * va[j][3]); sb += (vb[j][0] * vb[j][0] + vb[j][1] * vb[j][1]) + (vb[j][2] * vb[j][2] + vb[j][3] * vb[j][3]); }
#pragma unroll
    for (int o = 1; o < 64; o <<= 1) { sa += __shfl_xor(sa, o); sb += __shfl_xor(sb, o); }
    const float ma = sa * (1.f / 1024.f) + EPS, mb = sb * (1.f / 1024.f) + EPS;
    const float ra = rsqrtf(ma), rb = rsqrtf(mb);
    if (lane == 0) { *ri0 = sqrtf(ma); *ri1 = sqrtf(mb); }
    u32x2* pa = (u32x2*)o0 + lane; u32x2* pb = (u32x2*)o1 + lane;
#pragma unroll
    for (int j = 0; j < 4; ++j) { u32x2 w;
        w.x = pk2(va[j][0] * ra, va[j][1] * ra); w.y = pk2(va[j][2] * ra, va[j][3] * ra); pa[64 * j] = w;
        w.x = pk2(vb[j][0] * rb, vb[j][1] * rb); w.y = pk2(vb[j][2] * rb, vb[j][3] * rb); pb[64 * j] = w; }
}
__device__ __forceinline__ void rms_row_f32(float* xrow, const float* g, int lane) {
    f32x4* xr = (f32x4*)xrow + lane; const f32x4* gr = (const f32x4*)g + lane;
    f32x4 v[4]; float s = 0.f;
#pragma unroll
    for (int j = 0; j < 4; ++j) { v[j] = xr[64 * j]; s += (v[j][0] * v[j][0] + v[j][1] * v[j][1]) + (v[j][2] * v[j][2] + v[j][3] * v[j][3]); }
    const float r = rsqrtf(wave_sum(s) * (1.f / 1024.f) + EPS);
#pragma unroll
    for (int j = 0; j < 4; ++j) xr[64 * j] = v[j] * r * gr[64 * j];
}

__device__ __forceinline__ void cpow_table(float rho, float theta, int k, float& pr, float& pi) {
    const float mag = __expf(rho * (float)k);
    const double ang = (double)theta * (double)k; const double tw = 6.283185307179586476925286766559;
    const float red = (float)(ang - tw * __builtin_rint(ang / tw));
    pr = mag * cosf(red); pi = mag * sinf(red);
}
__device__ __forceinline__ void s5_tables_item(int item, LAS float* L, const float* a_re, const float* a_im, const float* log_dt, const float* b_re, const float* b_im,
                                               const float* c_re, const float* c_im, const float* dskip, bf16* Tg, bf16* Wg, float* L16, int tid) {
    const int g = item >> 2, kq = item & 3;
    LAS float* PWr = L; LAS float* PWi = L + 320;
    LAS float* cfr = L + 640; LAS float* cfi = L + 704;
    LAS float* Bbr = L + 768; LAS float* Bbi = Bbr + 1024; LAS float* Cr = Bbi + 1024; LAS float* Ci = Cr + 1024; LAS float* Kk = Ci + 1024;
    float brv[2], biv[2];
#pragma unroll
    for (int i = 0; i < 2; ++i) { const int e = tid + NTHR * i; Cr[e] = c_re[g * 1024 + e]; Ci[e] = c_im[g * 1024 + e]; brv[i] = b_re[g * 1024 + e]; biv[i] = b_im[g * 1024 + e]; }
    if (tid < 64) { const int n = tid; const float are = a_re[g * 64 + n], aim = a_im[g * 64 + n], dt = expf(log_dt[g]);
        const float rho = are * dt, theta = aim * dt;
        float lr, li; cpow_table(rho, theta, 1, lr, li);
        const float sh = sinf(0.5f * theta);
        const float nr = expm1f(rho) * cosf(theta) - 2.0f * sh * sh, ni = li;
        const float den = are * are + aim * aim;
        cfr[n] = (nr * are + ni * aim) / den; cfi[n] = (ni * are - nr * aim) / den;
#pragma unroll
        for (int j = 0; j < 5; ++j) { float pr, pi; cpow_table(rho, theta, 4 * kq + j, pr, pi); PWr[j * 64 + n] = pr; PWi[j * 64 + n] = pi;
            if (4 * kq + j == 16) { L16[g * 128 + n] = pr; L16[g * 128 + 64 + n] = pi; } }
    }
    __syncthreads();
#pragma unroll
    for (int i = 0; i < 2; ++i) { const int e = tid + NTHR * i, n = e >> 4; Bbr[e] = cfr[n] * brv[i] - cfi[n] * biv[i]; Bbi[e] = cfr[n] * biv[i] + cfi[n] * brv[i]; }
    __syncthreads();
    bf16* Tgg = Tg + (size_t)g * 256 * AEXT_LD;
    for (int kk = 0; kk < 4; ++kk) {
        const int k = 4 * kq + kk;
        const LAS float* Lkr = PWr + kk * 64; const LAS float* Lki = PWi + kk * 64; const LAS float* L1r = PWr + (kk + 1) * 64; const LAS float* L1i = PWi + (kk + 1) * 64;
        if (tid < 256) { const int ho = tid >> 4, hi = tid & 15; float sacc = 0.f;
            for (int n = 0; n < 64; ++n) { const float clr = Cr[ho * 64 + n] * Lkr[n] - Ci[ho * 64 + n] * Lki[n], cli = Cr[ho * 64 + n] * Lki[n] + Ci[ho * 64 + n] * Lkr[n];
                sacc += clr * Bbr[n * 16 + hi] - cli * Bbi[n * 16 + hi]; }
            if (k == 0 && ho == hi) sacc += dskip[g * 16 + ho];
            Kk[tid] = sacc; }
        __syncthreads();
        {
            const int bi = tid >> 5, ho = (tid & 31) >> 1, h8 = (tid & 1) * 8;
            if (bi >= k) { const int to = bi, ti = bi - k; const LAS float* sp = Kk + ho * 16 + h8;
                u32x4 w; w.x = pk2(sp[0], sp[1]); w.y = pk2(sp[2], sp[3]); w.z = pk2(sp[4], sp[5]); w.w = pk2(sp[6], sp[7]);
                *(u32x4*)(Tgg + (size_t)(to * 16 + ho) * AEXT_LD + ti * 16 + h8) = w; }
            if (k >= 1 && bi + k <= 15) { const int to = bi, ti = bi + k; *(u32x4*)(Tgg + (size_t)(to * 16 + ho) * AEXT_LD + ti * 16 + h8) = (u32x4){0u, 0u, 0u, 0u}; }
        }
        for (int e = tid; e < 1024; e += NTHR) { const int ho = e >> 6, n = e & 63;
            const float vr = Cr[e] * L1r[n] - Ci[e] * L1i[n], vi = Cr[e] * L1i[n] + Ci[e] * L1r[n];
            bf16* rowp = Tgg + (size_t)(k * 16 + ho) * AEXT_LD + 256;
            rowp[n] = (bf16)f2bf(vr); rowp[64 + n] = (bf16)f2bf(-vi); }
        {
            const int np = tid >> 1, h8 = (tid & 1) * 8, ti = 15 - k; float v[8];
#pragma unroll
            for (int x = 0; x < 8; ++x) { float val = 0.f;
                if (np < 128) { const int n = np & 63; const float br = Bbr[n * 16 + h8 + x], bi2 = Bbi[n * 16 + h8 + x];
                    val = np < 64 ? (Lkr[n] * br - Lki[n] * bi2) : (Lkr[n] * bi2 + Lki[n] * br); }
                v[x] = val; }
            u32x4 w; w.x = pk2(v[0], v[1]); w.y = pk2(v[2], v[3]); w.z = pk2(v[4], v[5]); w.w = pk2(v[6], v[7]);
            *(u32x4*)(Wg + ((size_t)g * 256 + np) * 256 + ti * 16 + h8) = w;
        }
        __syncthreads();
    }
}

__device__ __forceinline__ void s5_scan_item(int item, LAS float* L, const float* Sloc, const float* L16, bf16* Aext, int tid) {
    const int g = item >> 3, b = item & 7, seg = tid >> 6, n = tid & 63;
    const float ar = L16[g * 128 + n], ai = L16[g * 128 + 64 + n];
    const float* sl = Sloc + (size_t)(g * 2048 + b * 256 + seg * 32) * 128 + n;
    float srv[32], siv[32];
#pragma unroll
    for (int c = 0; c < 32; ++c) { srv[c] = sl[c * 128]; siv[c] = sl[c * 128 + 64]; }
    float er = 0.f, ei = 0.f;
#pragma unroll
    for (int c = 0; c < 32; ++c) { const float t = ar * er - ai * ei + srv[c]; ei = ar * ei + ai * er + siv[c]; er = t; }
    float pr = ar, pi = ai;
#pragma unroll
    for (int i = 0; i < 5; ++i) { const float t = pr * pr - pi * pi; pi = 2.f * pr * pi; pr = t; }
    L[(seg * 64 + n) * 2] = er; L[(seg * 64 + n) * 2 + 1] = ei;
    __syncthreads();
    float xr = 0.f, xi = 0.f;
    for (int s = 0; s < seg; ++s) { const float qr = L[(s * 64 + n) * 2], qi = L[(s * 64 + n) * 2 + 1]; const float t = pr * xr - pi * xi + qr; xi = pr * xi + pi * xr + qi; xr = t; }
    bf16* dst = Aext + (size_t)(g * 2048 + b * 256 + seg * 32) * AEXT_LD + 256 + n;
#pragma unroll
    for (int c = 0; c < 32; ++c) {
        dst[c * AEXT_LD] = (bf16)f2bf(xr); dst[c * AEXT_LD + 64] = (bf16)f2bf(xi);
        const float t = ar * xr - ai * xi + srv[c]; xi = ar * xi + ai * xr + siv[c]; xr = t; }
    __syncthreads();
}

constexpr int WB_P = 264;
constexpr int SL_P = 132;
__device__ __forceinline__ void s5_state_item(int item, LAS unsigned char* lds, const bf16* Wg, const float* L16, bf16* Aext, int tid) {
    const int g = item >> 3, b = item & 7;
    const int wid = tid >> 6, lane = tid & 63, l15 = lane & 15, g4 = lane >> 4, n = lane;
    LAS bf16* WB = (LAS bf16*)lds;
    LAS float* SL = (LAS float*)(lds + 128 * WB_P * 2);
    LAS float* EX = SL + 128 * SL_P;
    const bf16* wsrc = Wg + (size_t)g * 256 * 256;
#pragma unroll
    for (int i = 0; i < 8; ++i) { const int p = tid + 512 * i, row = p >> 5, cp = p & 31; *(LAS u32x4*)(WB + row * WB_P + cp * 8) = *(const u32x4*)(wsrc + row * 256 + cp * 8); }
    const bf16* arow = Aext + (size_t)(g * 2048 + b * 256) * AEXT_LD;
    bf16x8 af[2][8];
#pragma unroll
    for (int hf = 0; hf < 2; ++hf)
#pragma unroll
        for (int ks = 0; ks < 8; ++ks) af[hf][ks] = *(const bf16x8*)(arow + (size_t)(hf * 128 + wid * 16 + l15) * AEXT_LD + ks * 32 + 8 * g4);
    const float ar = L16[g * 128 + n], ai = L16[g * 128 + 64 + n];
    float pr = ar, pi = ai;
#pragma unroll
    for (int i = 0; i < 4; ++i) { const float t = pr * pr - pi * pi; pi = 2.f * pr * pi; pr = t; }
    float cr = 0.f, ci = 0.f;
    __syncthreads();
#pragma unroll
    for (int hf = 0; hf < 2; ++hf) {
        f32x4 acc[8];
#pragma unroll
        for (int nt = 0; nt < 8; ++nt) acc[nt] = (f32x4){0.f, 0.f, 0.f, 0.f};
#pragma unroll
        for (int ks = 0; ks < 8; ++ks)
#pragma unroll
            for (int nt = 0; nt < 8; ++nt) { const bf16x8 bfr = *(const LAS bf16x8*)(WB + (nt * 16 + l15) * WB_P + ks * 32 + 8 * g4);
                acc[nt] = __builtin_amdgcn_mfma_f32_16x16x32_bf16(af[hf][ks], bfr, acc[nt], 0, 0, 0); }
#pragma unroll
        for (int nt = 0; nt < 8; ++nt)
#pragma unroll
            for (int r = 0; r < 4; ++r) SL[(wid * 16 + 4 * g4 + r) * SL_P + nt * 16 + l15] = acc[nt][r];
        __syncthreads();
        float srv[16], siv[16]; float er = 0.f, ei = 0.f;
#pragma unroll
        for (int c = 0; c < 16; ++c) { srv[c] = SL[(wid * 16 + c) * SL_P + n]; siv[c] = SL[(wid * 16 + c) * SL_P + 64 + n]; }
#pragma unroll
        for (int c = 0; c < 16; ++c) { const float t = ar * er - ai * ei + srv[c]; ei = ar * ei + ai * er + siv[c]; er = t; }
        EX[(wid * 64 + n) * 2] = er; EX[(wid * 64 + n) * 2 + 1] = ei;
        __syncthreads();
        float xr = cr, xi = ci;
        for (int sg = 0; sg < wid; ++sg) { const float qr = EX[(sg * 64 + n) * 2], qi = EX[(sg * 64 + n) * 2 + 1]; const float t = pr * xr - pi * xi + qr; xi = pr * xi + pi * xr + qi; xr = t; }
        bf16* dst = Aext + (size_t)(g * 2048 + b * 256 + hf * 128 + wid * 16) * AEXT_LD + 256 + n;
#pragma unroll
        for (int c = 0; c < 16; ++c) {
            dst[c * AEXT_LD] = (bf16)f2bf(xr); dst[c * AEXT_LD + 64] = (bf16)f2bf(xi);
            const float t = ar * xr - ai * xi + srv[c]; xi = ar * xi + ai * xr + siv[c]; xr = t; }
        if (wid == 7) { EX[(8 * 64 + n) * 2] = xr; EX[(8 * 64 + n) * 2 + 1] = xi; }
        __syncthreads();
        cr = EX[(8 * 64 + n) * 2]; ci = EX[(8 * 64 + n) * 2 + 1];
    }
    __syncthreads();
}

constexpr int TB_P = 392;
constexpr int OT_P = 136;
__device__ __forceinline__ void s5_out_item(int item, LAS unsigned char* lds, const bf16* Tg, const bf16* Aext, bf16* Yg, int tid) {
    const int g = item >> 3, b = item & 7;
    const int wid = tid >> 6, lane = tid & 63, l15 = lane & 15, g4 = lane >> 4;
    LAS bf16* TB = (LAS bf16*)lds;
    const bf16* arow = Aext + (size_t)(g * 2048 + b * 256 + wid * 32) * AEXT_LD;
    bf16x8 af[2][12];
#pragma unroll
    for (int rt = 0; rt < 2; ++rt)
#pragma unroll
        for (int ks = 0; ks < 12; ++ks) af[rt][ks] = *(const bf16x8*)(arow + (size_t)(rt * 16 + l15) * AEXT_LD + ks * 32 + 8 * g4);
    bf16* ybase = Yg + (size_t)(g * 2048 + b * 256) * 256;
#pragma unroll 1
    for (int nh = 0; nh < 2; ++nh) {
        const bf16* tsrc = Tg + ((size_t)g * 256 + nh * 128) * AEXT_LD;
        __syncthreads();
#pragma unroll 1
        for (int i0 = 0; i0 < 12; i0 += 4) { u32x4 tv[4];
#pragma unroll
            for (int i = 0; i < 4; ++i) { const int p = tid + 512 * (i0 + i), row = p / 48, cp = p % 48; tv[i] = *(const u32x4*)(tsrc + (size_t)row * AEXT_LD + cp * 8); }
#pragma unroll
            for (int i = 0; i < 4; ++i) { const int p = tid + 512 * (i0 + i), row = p / 48, cp = p % 48; *(LAS u32x4*)(TB + row * TB_P + cp * 8) = tv[i]; } }
        __syncthreads();
        f32x4 acc[2][8];
#pragma unroll
        for (int rt = 0; rt < 2; ++rt)
#pragma unroll
            for (int nt = 0; nt < 8; ++nt) acc[rt][nt] = (f32x4){0.f, 0.f, 0.f, 0.f};
#pragma unroll
        for (int ks = 0; ks < 12; ++ks)
#pragma unroll
            for (int nt = 0; nt < 8; ++nt) { const bf16x8 tf = *(const LAS bf16x8*)(TB + (nt * 16 + l15) * TB_P + ks * 32 + 8 * g4);
                acc[0][nt] = __builtin_amdgcn_mfma_f32_16x16x32_bf16(tf, af[0][ks], acc[0][nt], 0, 0, 0);
                acc[1][nt] = __builtin_amdgcn_mfma_f32_16x16x32_bf16(tf, af[1][ks], acc[1][nt], 0, 0, 0); }
        __syncthreads();
        LAS bf16* OT = TB;
#pragma unroll
        for (int rt = 0; rt < 2; ++rt)
#pragma unroll
            for (int nt = 0; nt < 8; ++nt) { const f32x4 v = acc[rt][nt]; u32x2 w; w.x = pk2(fgelu_tanh(v[0]), fgelu_tanh(v[1])); w.y = pk2(fgelu_tanh(v[2]), fgelu_tanh(v[3]));
                *(LAS u32x2*)(OT + (wid * 32 + rt * 16 + l15) * OT_P + nt * 16 + 4 * g4) = w; }
#pragma unroll
        for (int i = 0; i < 8; ++i) { const int pp = lane + 64 * i, row = pp >> 4, cp = pp & 15;
            const u32x4 w = *(const LAS u32x4*)(OT + (wid * 32 + row) * OT_P + cp * 8);
            *(u32x4*)(ybase + (size_t)(wid * 32 + row) * 256 + nh * 128 + cp * 8) = w; }
    }
    __syncthreads();
}

typedef short s16x4 __attribute__((ext_vector_type(4)));
constexpr int RP = 72, RPV = 152;
__device__ __forceinline__ bf16x8 tr_frag8(LAS bf16* p0, int pitch) {
    const s16x4 a = __builtin_amdgcn_ds_read_tr16_b64_v4i16((LAS s16x4*)p0);
    const s16x4 b = __builtin_amdgcn_ds_read_tr16_b64_v4i16((LAS s16x4*)(p0 + 4 * pitch));
    return (bf16x8){a[0], a[1], a[2], a[3], b[0], b[1], b[2], b[3]};
}
template <bool FULL>
__device__ __forceinline__ void retention_item(int item, LAS unsigned char* lds, const bf16* Q, const bf16* Kb, const bf16* V, const bf16* SGR, float* KVseg, bf16* Ymix, int tid) {
    const int b = item >> 5, h = (item >> 2) & 7, seg = item & 3;
    const int wid = tid >> 6, lane = tid & 63, l15 = lane & 15, q4 = lane >> 4, tq = (lane & 15) >> 2, tp = lane & 3;
    LAS bf16* Qs = (LAS bf16*)lds; LAS bf16* Ks = Qs + 64 * RP; LAS bf16* KPs = Ks + 64 * RP; LAS bf16* Vs = KPs + 64 * RP;
    LAS bf16* Ps = Vs + 64 * RPV; LAS bf16* STs = Ps + 64 * RP; LAS float* stat = (LAS float*)(STs + 128 * RP);
    const float lg2 = log2f(1.0f - exp2f(-5.0f - (float)h));
    const float d64 = exp2f(lg2 * 64.0f);
    const int db = wid >> 1, ib = wid >> 1, hf = wid & 1, et0 = hf * 4;
    f32x4 Sacc[4];
#pragma unroll
    for (int t = 0; t < 4; ++t) Sacc[t] = (f32x4){0.f, 0.f, 0.f, 0.f};
    if (FULL) {
        const float w1024 = exp2f(lg2 * 1024.0f); float wgt = 1.0f;
        for (int s = seg - 1; s >= 0; --s) { const float* kv = KVseg + (size_t)((b * 8 + h) * 4 + s) * 8192;
#pragma unroll
            for (int t = 0; t < 4; ++t)
#pragma unroll
                for (int r = 0; r < 4; ++r) Sacc[t][r] += wgt * kv[(db * 16 + 4 * q4 + r) * 128 + (et0 + t) * 16 + l15];
            wgt *= w1024; }
#pragma unroll
        for (int t = 0; t < 4; ++t) { u32x2 w; w.x = pk2(Sacc[t][0], Sacc[t][1]); w.y = pk2(Sacc[t][2], Sacc[t][3]); *(LAS u32x2*)(STs + ((et0 + t) * 16 + l15) * RP + db * 16 + 4 * q4) = w; }
    }
    const int tok_seg = b * SEQ + seg * 1024;
    const int lrow = tid >> 3, lcp = tid & 7;
    const bf16* kptr = Kb + (size_t)(tok_seg + lrow) * 512 + h * 64 + lcp * 8;
    const bf16* qptr = Q + (size_t)(tok_seg + lrow) * 512 + h * 64 + lcp * 8;
    const bf16* vptr = V + (size_t)(tok_seg + (tid >> 4)) * 1024 + h * 128 + (tid & 15) * 8;
    const float kd = exp2f(lg2 * (float)(63 - lrow));
    const float qd = exp2f(lg2 * (float)(ib * 16 + l15 + 1));
    constexpr int PF = FULL ? 2 : 4;
    const bf16* gptr = SGR + (size_t)(tok_seg + ib * 16 + l15) * 1024 + h * 128 + et0 * 16 + 4 * q4;
    u32x4 kwS[PF], qwS[PF], vw0S[PF], vw1S[PF];
#pragma unroll
    for (int u = 0; u < PF; ++u) { const size_t o5 = (size_t)u * 64 * 512, o10 = (size_t)u * 64 * 1024;
        kwS[u] = *(const u32x4*)(kptr + o5); vw0S[u] = *(const u32x4*)(vptr + o10); vw1S[u] = *(const u32x4*)(vptr + o10 + 32 * 1024);
        if (FULL) qwS[u] = *(const u32x4*)(qptr + o5); }
    const int trV = (8 * q4 + tq) * RPV + 4 * tp, trK = (8 * q4 + tq) * RP + 4 * tp;
    float dec[2][4];
#pragma unroll
    for (int jj = 0; jj < 2; ++jj)
#pragma unroll
        for (int r = 0; r < 4; ++r) { const int dist = (ib * 16 + l15) - ((hf * 2 + jj) * 16 + 4 * q4 + r); dec[jj][r] = exp2f(lg2 * (float)(dist < 0 ? -dist : dist)); }
    for (int c0 = 0; c0 < 16; c0 += PF) {
#pragma unroll
      for (int u = 0; u < PF; ++u) {
        const int ch = c0 + u;
        const int tok0 = tok_seg + ch * 64;
        u32x2 gw[4];
        if (FULL) {
#pragma unroll
            for (int t = 0; t < 4; ++t) gw[t] = *(const u32x2*)(gptr + (size_t)ch * 64 * 1024 + t * 16); }
        {
            const u32x4 kw = kwS[u];
            if (FULL) { *(LAS u32x4*)(Ks + lrow * RP + lcp * 8) = kw; *(LAS u32x4*)(Qs + lrow * RP + lcp * 8) = qwS[u]; }
            f32x4 k0, k1; unpack8(kw, k0, k1); *(LAS u32x4*)(KPs + lrow * RP + lcp * 8) = pack8(k0 * kd, k1 * kd);
            *(LAS u32x4*)(Vs + (tid >> 4) * RPV + (tid & 15) * 8) = vw0S[u]; *(LAS u32x4*)(Vs + ((tid >> 4) + 32) * RPV + (tid & 15) * 8) = vw1S[u];
            if (ch + PF < 16) { const size_t o5 = (size_t)(ch + PF) * 64 * 512, o10 = (size_t)(ch + PF) * 64 * 1024;
                kwS[u] = *(const u32x4*)(kptr + o5); vw0S[u] = *(const u32x4*)(vptr + o10); vw1S[u] = *(const u32x4*)(vptr + o10 + 32 * 1024);
                if (FULL) qwS[u] = *(const u32x4*)(qptr + o5); }
        }
        __syncthreads();
        if (FULL) {
#pragma unroll
            for (int jj = 0; jj < 2; ++jj) { const int jb = hf * 2 + jj; f32x4 sacc = (f32x4){0.f, 0.f, 0.f, 0.f};
#pragma unroll
                for (int ks = 0; ks < 2; ++ks) { const bf16x8 af = *(const LAS bf16x8*)(Ks + (jb * 16 + l15) * RP + ks * 32 + 8 * q4); const bf16x8 bfr = *(const LAS bf16x8*)(Qs + (ib * 16 + l15) * RP + ks * 32 + 8 * q4);
                    sacc = __builtin_amdgcn_mfma_f32_16x16x32_bf16(af, bfr, sacc, 0, 0, 0); }
                const int i = ib * 16 + l15, j0 = jb * 16 + 4 * q4; float pv[4];
#pragma unroll
                for (int r = 0; r < 4; ++r) pv[r] = sacc[r] * dec[jj][r];
                u32x2 w; w.x = pk2(pv[0], pv[1]); w.y = pk2(pv[2], pv[3]); *(LAS u32x2*)(Ps + i * RP + j0) = w; }
        }
        bf16x8 vf[2][4];
#pragma unroll
        for (int ks = 0; ks < 2; ++ks)
#pragma unroll
            for (int t = 0; t < 4; ++t) vf[ks][t] = tr_frag8(Vs + ks * 32 * RPV + (et0 + t) * 16 + trV, RPV);
#pragma unroll
        for (int t = 0; t < 4; ++t) Sacc[t] = Sacc[t] * d64;
#pragma unroll
        for (int ks = 0; ks < 2; ++ks) { const bf16x8 kf = tr_frag8(KPs + ks * 32 * RP + db * 16 + trK, RP);
#pragma unroll
            for (int t = 0; t < 4; ++t) Sacc[t] = __builtin_amdgcn_mfma_f32_16x16x32_bf16(kf, vf[ks][t], Sacc[t], 0, 0, 0); }
        if (FULL) {
            __syncthreads();
            f32x4 oacc[4], cacc[4];
#pragma unroll
            for (int t = 0; t < 4; ++t) { oacc[t] = (f32x4){0.f, 0.f, 0.f, 0.f}; cacc[t] = (f32x4){0.f, 0.f, 0.f, 0.f}; }
#pragma unroll
            for (int ks = 0; ks < 2; ++ks) { const bf16x8 pb = *(const LAS bf16x8*)(Ps + (ib * 16 + l15) * RP + ks * 32 + 8 * q4); const bf16x8 qb = *(const LAS bf16x8*)(Qs + (ib * 16 + l15) * RP + ks * 32 + 8 * q4);
#pragma unroll
                for (int t = 0; t < 4; ++t) { const bf16x8 sa = *(const LAS bf16x8*)(STs + ((et0 + t) * 16 + l15) * RP + ks * 32 + 8 * q4);
                    oacc[t] = __builtin_amdgcn_mfma_f32_16x16x32_bf16(vf[ks][t], pb, oacc[t], 0, 0, 0); cacc[t] = __builtin_amdgcn_mfma_f32_16x16x32_bf16(sa, qb, cacc[t], 0, 0, 0); } }
            float s = 0.f, sq = 0.f;
#pragma unroll
            for (int t = 0; t < 4; ++t)
#pragma unroll
                for (int r = 0; r < 4; ++r) { const float o = oacc[t][r] + qd * cacc[t][r]; oacc[t][r] = o; s += o; sq += o * o; }
            s += __shfl_xor(s, 16); sq += __shfl_xor(sq, 16); s += __shfl_xor(s, 32); sq += __shfl_xor(sq, 32);
            const int i = ib * 16 + l15;
            if (q4 == 0) { *(LAS f32x2*)(stat + (i * 2 + hf) * 2) = (f32x2){s, sq}; }
            __syncthreads();
#pragma unroll
            for (int t = 0; t < 4; ++t) { u32x2 w; w.x = pk2(Sacc[t][0], Sacc[t][1]); w.y = pk2(Sacc[t][2], Sacc[t][3]); *(LAS u32x2*)(STs + ((et0 + t) * 16 + l15) * RP + db * 16 + 4 * q4) = w; }
            const f32x4 st = *(const LAS f32x4*)(stat + i * 4);
            const float mean = (st[0] + st[2]) * (1.f / 128.f); const float var = (st[1] + st[3]) * (1.f / 128.f) - mean * mean; const float rstd = rsqrtf(fmaxf(var, 0.f) + EPS);
            bf16* orow = Ymix + (size_t)(tok0 + i) * 2048 + 1024 + h * 128 + et0 * 16 + 4 * q4;
#pragma unroll
            for (int t = 0; t < 4; ++t) { const float g0 = bf2f(gw[t].x & 0xffffu), g1 = bf2f(gw[t].x >> 16), g2 = bf2f(gw[t].y & 0xffffu), g3 = bf2f(gw[t].y >> 16);
                u32x2 w; w.x = pk2((oacc[t][0] - mean) * rstd * g0, (oacc[t][1] - mean) * rstd * g1); w.y = pk2((oacc[t][2] - mean) * rstd * g2, (oacc[t][3] - mean) * rstd * g3);
                *(u32x2*)(orow + t * 16) = w; }
        }
        __syncthreads();
      }
    }
    if (!FULL) { float* kv = KVseg + (size_t)item * 8192;
#pragma unroll
        for (int t = 0; t < 4; ++t)
#pragma unroll
            for (int r = 0; r < 4; ++r) kv[(db * 16 + 4 * q4 + r) * 128 + (et0 + t) * 16 + l15] = Sacc[t][r]; }
}

constexpr int RPP = 136;
__device__ __forceinline__ void retention_full_item(const int MODE, int item, LAS unsigned char* lds, const bf16* Q, const bf16* Kb, const bf16* V, const bf16* SGR, const float* KVseg, bf16* Ymix, int tid) {
    const int b = item >> 5, h = (item >> 2) & 7, seg = item & 3;
    const int wid = __builtin_amdgcn_readfirstlane(tid >> 6), lane = tid & 63, l15 = lane & 15, q4 = lane >> 4, tq = (lane & 15) >> 2, tp = lane & 3;
    LAS bf16* Qs = (LAS bf16*)lds; LAS bf16* Ks = Qs + 128 * RP; LAS bf16* KPs = Ks + 128 * RP; LAS bf16* Vs = KPs + 128 * RP;
    LAS bf16* Ps = Vs + 128 * RPV; LAS bf16* STs = Ps + 128 * RPP;
    const float lg2 = log2f(1.0f - exp2f(-5.0f - (float)h));
    const float d128 = exp2f(lg2 * 128.0f);
    const int db = wid >> 1, et0 = (wid & 1) * 4;
    const int irow = wid * 16 + l15;
    const bool second = wid >= 4;
    f32x4 Sacc[4];
#pragma unroll
    for (int t = 0; t < 4; ++t) Sacc[t] = (f32x4){0.f, 0.f, 0.f, 0.f};
    {
        const float w1024 = exp2f(lg2 * 1024.0f); float wgt = 1.0f;
        for (int s = seg - 1; s >= 0; --s) { const float* kv = KVseg + (size_t)((b * 8 + h) * 4 + s) * 8192;
#pragma unroll
            for (int t = 0; t < 4; ++t)
#pragma unroll
                for (int r = 0; r < 4; ++r) Sacc[t][r] += wgt * kv[(db * 16 + 4 * q4 + r) * 128 + (et0 + t) * 16 + l15];
            wgt *= w1024; }
#pragma unroll
        for (int t = 0; t < 4; ++t) { u32x2 w; w.x = pk2(Sacc[t][0], Sacc[t][1]); w.y = pk2(Sacc[t][2], Sacc[t][3]); *(LAS u32x2*)(STs + ((et0 + t) * 16 + l15) * RP + db * 16 + 4 * q4) = w; }
    }
    const int tok_seg = b * SEQ + seg * 1024;
    const int krow = tid >> 3, kcp = tid & 7, vrow = tid >> 4, vcp = tid & 15;
    const bf16* kptr = Kb + (size_t)(tok_seg + krow) * 512 + h * 64 + kcp * 8;
    const bf16* qptr = Q + (size_t)(tok_seg + krow) * 512 + h * 64 + kcp * 8;
    const bf16* vptr = V + (size_t)(tok_seg + vrow) * 1024 + h * 128 + vcp * 8;
    const bf16* gptr2 = SGR + (size_t)(tok_seg + wid * 16 + q4) * 1024 + h * 128 + l15 * 8;
    bf16* optr2 = Ymix + (size_t)(tok_seg + wid * 16 + q4) * 2048 + 1024 + h * 128 + l15 * 8;
    const float kd0 = exp2f(lg2 * (float)(127 - krow)), kd1 = exp2f(lg2 * (float)(63 - krow));
    const float qd = exp2f(lg2 * (float)(irow + 1));
    u32x4 kw[2], qw[2], vw[4];
#pragma unroll
    for (int i = 0; i < 2; ++i) { kw[i] = *(const u32x4*)(kptr + (size_t)i * 64 * 512); qw[i] = *(const u32x4*)(qptr + (size_t)i * 64 * 512); }
#pragma unroll
    for (int i = 0; i < 4; ++i) vw[i] = *(const u32x4*)(vptr + (size_t)i * 32 * 1024);
    const int trV = (8 * q4 + tq) * RPV + 4 * tp, trK = (8 * q4 + tq) * RP + 4 * tp;
#pragma unroll 1
    for (int it = 0; it < 8; ++it) {
        {
#pragma unroll
            for (int i = 0; i < 2; ++i) { const int row = krow + 64 * i;
                *(LAS u32x4*)(Ks + row * RP + kcp * 8) = kw[i]; *(LAS u32x4*)(Qs + row * RP + kcp * 8) = qw[i];
                f32x4 k0, k1; unpack8(kw[i], k0, k1); const float kd = i == 0 ? kd0 : kd1; *(LAS u32x4*)(KPs + row * RP + kcp * 8) = pack8(k0 * kd, k1 * kd); }
#pragma unroll
            for (int i = 0; i < 4; ++i) *(LAS u32x4*)(Vs + (vrow + 32 * i) * RPV + vcp * 8) = vw[i];
            if (it < 7 && MODE < 2) { const size_t o5 = (size_t)(it + 1) * 128 * 512, o10 = (size_t)(it + 1) * 128 * 1024;
#pragma unroll
                for (int i = 0; i < 2; ++i) { kw[i] = *(const u32x4*)(kptr + o5 + (size_t)i * 64 * 512); qw[i] = *(const u32x4*)(qptr + o5 + (size_t)i * 64 * 512); }
#pragma unroll
                for (int i = 0; i < 4; ++i) vw[i] = *(const u32x4*)(vptr + o10 + (size_t)i * 32 * 1024); }
        }
        __syncthreads();
        if (MODE < 3)
        {
            bf16x8 qf[2];
#pragma unroll
            for (int ks = 0; ks < 2; ++ks) qf[ks] = *(const LAS bf16x8*)(Qs + irow * RP + ks * 32 + 8 * q4);
#pragma unroll
            for (int jt = 0; jt < 8; ++jt) {
                if (jt < 4 || second) {
                    f32x4 sacc = (f32x4){0.f, 0.f, 0.f, 0.f};
#pragma unroll
                    for (int ks = 0; ks < 2; ++ks) { const bf16x8 af = *(const LAS bf16x8*)(Ks + (jt * 16 + l15) * RP + ks * 32 + 8 * q4); sacc = __builtin_amdgcn_mfma_f32_16x16x32_bf16(af, qf[ks], sacc, 0, 0, 0); }
                    const int j0 = jt * 16 + 4 * q4; float pv[4];
#pragma unroll
                    for (int r = 0; r < 4; ++r) { const int dist = irow - (j0 + r); pv[r] = sacc[r] * __builtin_amdgcn_exp2f(lg2 * (float)(dist < 0 ? -dist : dist)); }
                    u32x2 w; w.x = pk2(pv[0], pv[1]); w.y = pk2(pv[2], pv[3]); *(LAS u32x2*)(Ps + irow * RPP + j0) = w;
                }
            }
        }
        f32x4 oacc[8];
#pragma unroll
        for (int et = 0; et < 8; ++et) oacc[et] = (f32x4){0.f, 0.f, 0.f, 0.f};
#pragma unroll
        for (int t = 0; t < 4; ++t) Sacc[t] = Sacc[t] * d128;
#pragma unroll
        for (int ks = 0; ks < (MODE < 3 ? 4 : 0); ++ks) {
            bf16x8 vf[8];
#pragma unroll
            for (int et = 0; et < 8; ++et) vf[et] = tr_frag8(Vs + ks * 32 * RPV + et * 16 + trV, RPV);
            const bf16x8 kf = tr_frag8(KPs + ks * 32 * RP + db * 16 + trK, RP);
            if (wid & 1) {
#pragma unroll
                for (int t = 0; t < 4; ++t) Sacc[t] = __builtin_amdgcn_mfma_f32_16x16x32_bf16(kf, vf[4 + t], Sacc[t], 0, 0, 0);
            } else {
#pragma unroll
                for (int t = 0; t < 4; ++t) Sacc[t] = __builtin_amdgcn_mfma_f32_16x16x32_bf16(kf, vf[t], Sacc[t], 0, 0, 0);
            }
            if (ks < 2 || second) { const bf16x8 pb = *(const LAS bf16x8*)(Ps + irow * RPP + ks * 32 + 8 * q4);
#pragma unroll
                for (int et = 0; et < 8; ++et) oacc[et] = __builtin_amdgcn_mfma_f32_16x16x32_bf16(vf[et], pb, oacc[et], 0, 0, 0); }
            if (ks < 2) {
                const u32x4 qraw = *(const LAS u32x4*)(Qs + irow * RP + ks * 32 + 8 * q4); f32x4 q0, q1; unpack8(qraw, q0, q1);
                const u32x4 qsc = pack8(q0 * qd, q1 * qd); const bf16x8 qb = __builtin_bit_cast(bf16x8, qsc);
#pragma unroll
                for (int et = 0; et < 8; ++et) { const bf16x8 sa = *(const LAS bf16x8*)(STs + (et * 16 + l15) * RP + ks * 32 + 8 * q4); oacc[et] = __builtin_amdgcn_mfma_f32_16x16x32_bf16(sa, qb, oacc[et], 0, 0, 0); } }
        }
        u32x4 gq[4];
#pragma unroll
        for (int i = 0; i < 4; ++i) { if (MODE == 0) gq[i] = *(const u32x4*)(gptr2 + (size_t)it * 128 * 1024 + (size_t)i * 4 * 1024); else gq[i] = (u32x4){0x3f803f80u, 0x3f803f80u, 0x3f803f80u, 0x3f803f80u}; }
        float s = 0.f, sq = 0.f;
#pragma unroll
        for (int et = 0; et < 8; ++et)
#pragma unroll
            for (int r = 0; r < 4; ++r) { const float o = oacc[et][r]; s += o; sq += o * o; }
        s += __shfl_xor(s, 16); sq += __shfl_xor(sq, 16); s += __shfl_xor(s, 32); sq += __shfl_xor(sq, 32);
        const float mean = s * (1.f / 128.f); const float var = sq * (1.f / 128.f) - mean * mean; const float rstd = rsqrtf(fmaxf(var, 0.f) + EPS);
#pragma unroll
        for (int et = 0; et < 8; ++et) { u32x2 w; w.x = pk2((oacc[et][0] - mean) * rstd, (oacc[et][1] - mean) * rstd); w.y = pk2((oacc[et][2] - mean) * rstd, (oacc[et][3] - mean) * rstd);
            *(LAS u32x2*)(Ps + irow * RPP + et * 16 + 4 * q4) = w; }
        __syncthreads();
#pragma unroll
        for (int t = 0; t < 4; ++t) { u32x2 w; w.x = pk2(Sacc[t][0], Sacc[t][1]); w.y = pk2(Sacc[t][2], Sacc[t][3]); *(LAS u32x2*)(STs + ((et0 + t) * 16 + l15) * RP + db * 16 + 4 * q4) = w; }
#pragma unroll
        for (int i = 0; i < 4; ++i) { const u32x4 nv = *(const LAS u32x4*)(Ps + (wid * 16 + q4 + 4 * i) * RPP + l15 * 8);
            f32x4 n0, n1, g0, g1; unpack8(nv, n0, n1); unpack8(gq[i], g0, g1);
#pragma unroll
            for (int x = 0; x < 4; ++x) { g0[x] = fsilu(g0[x]); g1[x] = fsilu(g1[x]); }
            const u32x4 w = pack8(n0 * g0, n1 * g1);
            if (MODE == 0) *(u32x4*)(optr2 + (size_t)it * 128 * 2048 + (size_t)i * 4 * 2048) = w; else asm volatile("" :: "v"(w.x), "v"(w.y), "v"(w.z), "v"(w.w)); }
    }
    __syncthreads();
}

struct ConvRegs { f32x2 w[31]; f32x2 bias; f32x4 lg[4], lb[4]; };
__device__ __forceinline__ void conv_load_regs(ConvRegs& R, const float* cw, const float* cb, const float* lng, const float* lnb, int tid) {
    const int c0 = 2 * tid, lane = tid & 63;
#pragma unroll
    for (int k = 0; k < 31; ++k) R.w[k] = *(const f32x2*)(cw + k * 1024 + c0);
    R.bias = *(const f32x2*)(cb + c0);
#pragma unroll
    for (int q = 0; q < 4; ++q) { R.lg[q] = *(const f32x4*)(lng + lane * 4 + 256 * q); R.lb[q] = *(const f32x4*)(lnb + lane * 4 + 256 * q); }
}
__device__ __forceinline__ void conv_item(const int MODE, int item, LAS unsigned char* lds, const bf16* U2, const bf16* SG2, const ConvRegs& R, bf16* V2, int tid) {
    const int b = item >> 7, l0 = (item & 127) * 32, c0 = 2 * tid;
    LAS float* T = (LAS float*)lds;
    const char* ub = (const char*)U2;
#pragma unroll 1
    for (int hf = 0; hf < 2; ++hf) {
        unsigned uraw[46]; const int lb = l0 - 30 + hf * 16;
#pragma unroll
        for (int j = 0; j < 46; ++j) { const int l = lb + j; const int lc = l < 0 ? 0 : l;
            if (MODE < 2) uraw[j] = *(const unsigned*)(ub + ((unsigned)(b * SEQ + lc) * 2048u + (unsigned)c0 * 2u)); else uraw[j] = 0x3f803f80u; }
        f32x2 u[46];
#pragma unroll
        for (int j = 0; j < 46; ++j) { const unsigned uw = (lb + j) < 0 ? 0u : uraw[j]; u[j][0] = bf2f(uw & 0xffffu); u[j][1] = bf2f(uw >> 16); }
#pragma unroll
        for (int t = 0; t < 16; ++t) { f32x2 a = R.bias;
            if (MODE < 3)
#pragma unroll
            for (int k = 0; k < 31; ++k) a += R.w[k] * u[t + k];
            *(LAS f32x2*)(T + (hf * 16 + t) * 1024 + c0) = a; }
    }
    const int wid = tid >> 6, lane = tid & 63;
    const size_t tokb = (size_t)(b * SEQ + l0 + wid * 4);
    u32x2 gt[4][4];
#pragma unroll
    for (int tt = 0; tt < 4; ++tt)
#pragma unroll
        for (int q = 0; q < 4; ++q) { if (MODE == 0) gt[tt][q] = *(const u32x2*)(SG2 + (tokb + tt) * 1024 + lane * 4 + 256 * q); else gt[tt][q] = (u32x2){0x3f803f80u, 0x3f803f80u}; }
    __syncthreads();
    f32x4 v[4][4]; float s[4], s2[4];
#pragma unroll
    for (int tt = 0; tt < 4; ++tt) { s[tt] = 0.f;
#pragma unroll
        for (int q = 0; q < 4; ++q) { v[tt][q] = *(const LAS f32x4*)(T + (wid * 4 + tt) * 1024 + lane * 4 + 256 * q); s[tt] += (v[tt][q][0] + v[tt][q][1]) + (v[tt][q][2] + v[tt][q][3]); } }
#pragma unroll
    for (int o = 1; o < 64; o <<= 1)
#pragma unroll
        for (int tt = 0; tt < 4; ++tt) s[tt] += __shfl_xor(s[tt], o);
#pragma unroll
    for (int tt = 0; tt < 4; ++tt) { const float mean = s[tt] * (1.f / 1024.f); s2[tt] = 0.f;
#pragma unroll
        for (int q = 0; q < 4; ++q) { v[tt][q] = v[tt][q] - mean; s2[tt] += (v[tt][q][0] * v[tt][q][0] + v[tt][q][1] * v[tt][q][1]) + (v[tt][q][2] * v[tt][q][2] + v[tt][q][3] * v[tt][q][3]); } }
#pragma unroll
    for (int o = 1; o < 64; o <<= 1)
#pragma unroll
        for (int tt = 0; tt < 4; ++tt) s2[tt] += __shfl_xor(s2[tt], o);
#pragma unroll
    for (int tt = 0; tt < 4; ++tt) { const float rstd = rsqrtf(s2[tt] * (1.f / 1024.f) + EPS);
#pragma unroll
        for (int q = 0; q < 4; ++q) { const u32x2 gw = gt[tt][q]; float o[4];
            const float g4[4] = {bf2f(gw.x & 0xffffu), bf2f(gw.x >> 16), bf2f(gw.y & 0xffffu), bf2f(gw.y >> 16)};
#pragma unroll
            for (int i = 0; i < 4; ++i) { const float tv = v[tt][q][i] * rstd * R.lg[q][i] + R.lb[q][i]; o[i] = tv * g4[i] * fsig2(tv, g4[i]); }
            u32x2 w; w.x = pk2(o[0], o[1]); w.y = pk2(o[2], o[3]); if (MODE == 0) *(u32x2*)(V2 + (tokb + tt) * 1024 + lane * 4 + 256 * q) = w; else asm volatile("" :: "v"(w.x), "v"(w.y)); } }
    __syncthreads();
}

typedef GAS unsigned gu32;
#define RLX_AGENT __ATOMIC_RELAXED, __HIP_MEMORY_SCOPE_AGENT
#define XB_TMO      128
#define XB_XCNT(j)  (256  + 64 * (j))
#define XB_XSUB(j)  (1280 + 64 * (j))
#define XB_XGEN(j)  (2304 + 64 * (j))
#define XB_TOP      3328
#define XB_TOPGEN   3392
#define XCD_BAR_WORDS 3456
#define XB_SPIN_CAP (1u << 18)

__device__ __forceinline__ unsigned xb_ld(unsigned* p)              { return __hip_atomic_load(p, __ATOMIC_RELAXED, __HIP_MEMORY_SCOPE_AGENT); }
__device__ __forceinline__ unsigned xb_add(unsigned* p, unsigned v) { return __hip_atomic_fetch_add(p, v, __ATOMIC_RELAXED, __HIP_MEMORY_SCOPE_AGENT); }
__device__ __forceinline__ unsigned xb_xcc_id() { return (unsigned)__builtin_amdgcn_s_getreg((3 << 11) | 20) & 0xFu; }
#define XB_SPIN(cond, bar) do { unsigned _sp = 0; while (cond) { __builtin_amdgcn_s_sleep(1); \
    if ((++_sp & 255u) == 0u) { if (xb_ld(&(bar)[XB_TMO])) break; if (_sp > XB_SPIN_CAP) { atomicAdd(&(bar)[XB_TMO], 1u); break; } } } } while (0)

struct XcdBarrier {
    unsigned* bar; unsigned x;
    volatile LAS unsigned* st;
};

__device__ __forceinline__ XcdBarrier xcd_barrier_post(unsigned* bar, volatile LAS unsigned* st) {
    XcdBarrier b; b.bar = bar; b.x = xb_xcc_id(); b.st = st;
    if (threadIdx.x == 0) (void)xb_add(&bar[XB_XCNT(b.x)], 1u);
    return b;
}
__device__ __forceinline__ void xcd_barrier_complete(unsigned* bar, unsigned x, unsigned& nloc, unsigned& nx) {
    const unsigned G = gridDim.x * gridDim.y * gridDim.z;
    unsigned sum, cnt, mine, sp = 0u;
    for (;;) {
        sum = 0u; cnt = 0u; mine = 0u;
#pragma unroll
        for (unsigned j = 0; j < 16; ++j) { const unsigned c = xb_ld(&bar[XB_XCNT(j)]); sum += c; cnt += (c > 0u) ? 1u : 0u; mine = (j == x) ? c : mine; }
        if (sum == G) break;
        __builtin_amdgcn_s_sleep(1);
        if ((++sp & 255u) == 0u) { if (xb_ld(&bar[XB_TMO])) break; if (sp > XB_SPIN_CAP) { atomicAdd(&bar[XB_TMO], 1u); break; } }
    }
    nloc = mine > 0u ? mine : 1u; nx = cnt > 0u ? cnt : 1u;
}

__device__ __forceinline__ void xcd_barrier(const XcdBarrier& b) {
    asm volatile("s_waitcnt vmcnt(0)" ::: "memory");
    __syncthreads();
    if (threadIdx.x == 0) {
        unsigned* bar = b.bar;
        __builtin_amdgcn_s_waitcnt(0);
        unsigned nloc = b.st[0], nx = b.st[1];
        if (nloc == 0u) { xcd_barrier_complete(bar, b.x, nloc, nx); b.st[0] = nloc; b.st[1] = nx; }
        const unsigned old = xb_add(&bar[XB_XSUB(b.x)], 1u);
        const unsigned gen = old / nloc;
        if (old + 1u == (gen + 1u) * nloc) {
            __builtin_amdgcn_fence(__ATOMIC_RELEASE, "agent");
            asm volatile("s_waitcnt vmcnt(0)" ::: "memory");
            const unsigned og = xb_add(&bar[XB_TOP], 1u);
            const unsigned tg = og / nx;
            if (og + 1u == (tg + 1u) * nx) xb_add(&bar[XB_TOPGEN], 1u);
            else XB_SPIN(xb_ld(&bar[XB_TOPGEN]) == tg, bar);
            __builtin_amdgcn_fence(__ATOMIC_ACQUIRE, "agent");
            xb_add(&bar[XB_XGEN(b.x)], 1u);
            asm volatile("s_waitcnt vmcnt(0)" ::: "memory");
        } else {
            XB_SPIN(xb_ld(&bar[XB_XGEN(b.x)]) == gen, bar);
            __builtin_amdgcn_fence(__ATOMIC_ACQUIRE, "agent");
            asm volatile("s_waitcnt vmcnt(0)" ::: "memory");
        }
    }
    __syncthreads();
}


#ifndef MK_PER_PHASE
#define MK_PER_PHASE 0
#endif
#ifndef PROBE_RET1_REPS
#define PROBE_RET1_REPS 1
#endif
#ifndef PROBE_RET3_REPS
#define PROBE_RET3_REPS 1
#endif
#ifndef PROBE_S5A_REPS
#define PROBE_S5A_REPS 1
#endif
#ifndef PROBE_TS_A
#define PROBE_TS_A -1
#endif
#ifndef PROBE_TS_B
#define PROBE_TS_B -1
#endif
#ifndef PROBE_P0A
#define PROBE_P0A 1
#endif
#ifndef PROBE_P0B
#define PROBE_P0B 1
#endif
#ifndef PROBE_P0C
#define PROBE_P0C 1
#endif
#ifndef PG_ALIGN_MAIN
#define PG_ALIGN_MAIN true
#endif
#ifndef PROBE_S5B_REPS
#define PROBE_S5B_REPS 1
#endif
#ifndef PROBE_RET3_MODE
#define PROBE_RET3_MODE 0
#endif
#ifndef PROBE_CONV_REPS
#define PROBE_CONV_REPS 1
#endif
#ifndef PROBE_CONV_MODE
#define PROBE_CONV_MODE 0
#endif
#ifndef PROBE_S5B2
#define PROBE_S5B2 0
#endif
#ifndef PROBE_DUP_MASK
#define PROBE_DUP_MASK 0
#endif
constexpr int N_PHASES = 8;
struct Args { const float* in[21]; float* out; unsigned char* ws; int ph_lo, ph_hi; };

__global__ void __launch_bounds__(NTHR, 2) fwd_megakernel(Args args) {
    extern __shared__ __attribute__((aligned(16))) unsigned char lds_raw[];
    LAS unsigned char* lds = (LAS unsigned char*)lds_raw;
    const int tid = threadIdx.x, lane = tid & 63, wave = __builtin_amdgcn_readfirstlane(tid >> 6);
    const int G = gridDim.x, bid = blockIdx.x;
    const int gw = bid * NWAVES + wave, NGW = G * NWAVES;
    unsigned char* ws = args.ws;
    const float* x = args.in[0]; const float* norm_g = args.in[1]; const float* final_g = args.in[2]; const float* w_in_ab = args.in[3];
    const float* s5_a_re = args.in[4]; const float* s5_a_im = args.in[5]; const float* s5_log_dt = args.in[6]; const float* s5_b_re = args.in[7]; const float* s5_b_im = args.in[8];
    const float* s5_c_re = args.in[9]; const float* s5_c_im = args.in[10]; const float* s5_d = args.in[11]; const float* s5_glu_w = args.in[12]; const float* s5_glu_b = args.in[13];
    const float* w_out_ab = args.in[14]; const float* w_in_c = args.in[15]; const float* conv_w = args.in[16]; const float* conv_b = args.in[17];
    const float* conv_ln_g = args.in[18]; const float* conv_ln_b = args.in[19]; const float* w_out_c = args.in[20];
    float* out = args.out;
    float* ss1 = (float*)(ws + WS_CTL); float* ss2 = ss1 + M; float* rinv = (float*)(ws + WS_CTL + 327680);
    float* ropec = (float*)(ws + WS_ROPE); float* ropes = ropec + 4096 * 32;
    bf16* WinT = (bf16*)(ws + WS_WIN); bf16* WgluT = (bf16*)(ws + WS_WGLU); bf16* WoutT = (bf16*)(ws + WS_WOUT); bf16* WincT = (bf16*)(ws + WS_WINC); bf16* WoutcT = (bf16*)(ws + WS_WOUTC);
    bf16* Tg = (bf16*)(ws + WS_TG); bf16* Wg = (bf16*)(ws + WS_WG); float* L16 = (float*)(ws + WS_L16); float* KVseg = (float*)(ws + WS_KVSEG);
    bf16* XN = (bf16*)(ws + WS_XN); float* Sloc = (float*)(ws + WS_XN); bf16* Yg = (bf16*)(ws + WS_XN); bf16* XG2 = (bf16*)(ws + WS_XN);
    bf16* Aext = (bf16*)(ws + WS_AEXT); bf16* SG5 = (bf16*)(ws + WS_SG5); bf16* Qb = (bf16*)(ws + WS_Q); bf16* Kb = (bf16*)(ws + WS_K); bf16* Vb = (bf16*)(ws + WS_V); bf16* SGR = (bf16*)(ws + WS_SGR);
    float* X1 = (float*)(ws + WS_X1); bf16* U2 = (bf16*)(ws + WS_U2); bf16* SG2 = (bf16*)(ws + WS_SG2); bf16* V2 = (bf16*)(ws + WS_V2);
    bf16* Ymix = (bf16*)out;

    const int lo = args.ph_lo, hi = args.ph_hi;
#define IN(k) (lo <= (k) && (k) < hi)
#define SEAM(k) do { if (IN(k) && IN((k) + 1)) { if ((k) == 0) cg::this_grid().sync(); else xcd_barrier(xbar); if (PROBE_TS_A >= 0 && bid == 0 && tid == 0) tsw[(k) + 1] = __builtin_amdgcn_s_memrealtime(); } } while (0)
    unsigned long long* tsw = (unsigned long long*)(ws + WS_CTL + 786432);
    if (PROBE_TS_A >= 0 && bid == 0 && tid == 0) tsw[0] = __builtin_amdgcn_s_memrealtime();
    if (tid < 4) ((volatile LAS unsigned*)(lds + 155392))[tid] = 0u;
    __syncthreads();
    XcdBarrier xbar; xbar.bar = (unsigned*)(ws + WS_CTL + 524288); xbar.x = 0; xbar.st = (volatile LAS unsigned*)(lds + 155392);
    if (hi - lo > 1) xbar = xcd_barrier_post((unsigned*)(ws + WS_CTL + 524288), (volatile LAS unsigned*)(lds + 155392));

    if (IN(0)) {
        LAS float* scr = (LAS float*)(lds + wave * 16384);
        constexpr int I_IN = 16 * 160, I_GLU = 16 * 32, I_OUT = 32 * 32, I_INC = 16 * 96, I_OUTC = 16 * 32;
        constexpr int NITEMS = I_IN + I_GLU + I_OUT + I_INC + I_OUTC;
        for (int rep = 0; rep < PROBE_P0A; ++rep) for (int it = gw; it < NITEMS; it += NGW) {
            int r = it;
            if (r < I_IN) { p0_transpose_item(w_in_ab, 1024, 5120, WinT, 1, scr, r, lane, norm_g); continue; } r -= I_IN;
            if (r < I_GLU) { p0_transpose_item(s5_glu_w, 1024, 1024, WgluT, 0, scr, r, lane); continue; } r -= I_GLU;
            if (r < I_OUT) { p0_transpose_item(w_out_ab, 2048, 1024, WoutT, 0, scr, r, lane); continue; } r -= I_OUT;
            if (r < I_INC) { p0_transpose_item(w_in_c, 1024, 3072, WincT, 2, scr, r, lane, norm_g + 1024); continue; } r -= I_INC;
            p0_transpose_item(w_out_c, 1024, 1024, WoutcT, 0, scr, r, lane);
        }
        for (int e = bid * NTHR + tid; e < 4096 * 32; e += G * NTHR) { const int pos = e >> 5, f = e & 31;
            const double freq = exp(-(double)f * (9.210340371976182736 / 32.0)); const double ang = (double)pos * freq; const double tw = 6.283185307179586476925286766559;
            const float red = (float)(ang - tw * __builtin_rint(ang / tw)); ropec[e] = cosf(red); ropes[e] = sinf(red); }
        __syncthreads();
        for (int rep = 0; rep < PROBE_P0B; ++rep) for (int it = bid; it < 256; it += G) s5_tables_item(it, (LAS float*)lds, s5_a_re, s5_a_im, s5_log_dt, s5_b_re, s5_b_im, s5_c_re, s5_c_im, s5_d, Tg, Wg, L16, tid);
        for (int rep = 0; rep < PROBE_P0C; ++rep) for (int m = gw; m < M; m += 2 * NGW) { const int m2 = m + NGW; rms_rows2_plain(x + (size_t)m * DM, x + (size_t)m2 * DM, XN + (size_t)m * DM, XN + (size_t)m2 * DM, rinv + m, rinv + m2, lane); }
    }
    SEAM(0);
    if (IN(1)) {
        pg8::Gemm g{XN, WinT, 1024, 1024, 1024, 0, 0}; pg8::StaticOrder S; S.init(M, 5120, G, bid);
        EpiWin E{Aext, SG5, Qb, Kb, Vb, SGR, ropec, ropes};
        pg8::gemm_phase<EpiWin, pg8::StaticOrder, PG_ALIGN_MAIN, false>(lds, g, S, E);
    }
    SEAM(1);
#define WG_LOCAL_SEAM() do { asm volatile("s_waitcnt vmcnt(0)" ::: "memory"); __syncthreads(); __builtin_amdgcn_fence(__ATOMIC_ACQUIRE, "agent"); asm volatile("s_waitcnt vmcnt(0)" ::: "memory"); __syncthreads(); } while (0)
    if (IN(2)) {
        const int vb = (G % 8 == 0) ? (bid % 8) * (G / 8) + bid / 8 : bid;
        for (int rep = 0; rep < PROBE_S5A_REPS; ++rep) for (int it = vb; it < 512; it += G) s5_state_item(it, lds, Wg, L16, Aext, tid);
        WG_LOCAL_SEAM();
        for (int rep = 0; rep < PROBE_S5B_REPS; ++rep) { pg8::Gemm g{Aext, Tg, AEXT_LD, AEXT_LD, AEXT_LD, 0, 0}; pg8::GroupOrder S{G, vb};
          EpiYg E{Aext};
          pg8::gemm_phase<EpiYg, pg8::GroupOrder, true, false>(lds, g, S, E); }
        for (int rep = 0; rep < PROBE_RET1_REPS; ++rep) for (int it = bid; it < 256; it += G) { if ((it & 3) != 3) retention_item<false>(it, lds, Qb, Kb, Vb, SGR, KVseg, Ymix, tid); }
    }
    SEAM(2);
    if (IN(3)) {
        for (int rep = 0; rep < PROBE_RET3_REPS; ++rep) for (int it = bid; it < 256; it += G) retention_full_item(rep == 0 ? 0 : PROBE_RET3_MODE, it, lds, Qb, Kb, Vb, SGR, KVseg, Ymix, tid);
        { pg8::Gemm g{Aext, WgluT, 1024, 0, 1024, 1, 0, 1572864u, 65536u}; pg8::StaticOrder S; S.init(M, 1024, G, bid);
          EpiGlu E{Aext, SG5, s5_glu_b, Ymix};
          pg8::gemm_phase<EpiGlu, pg8::StaticOrder, PG_ALIGN_MAIN, false>(lds, g, S, E); }
    }
    SEAM(3);
    if (IN(4)) {
        pg8::Gemm g{Ymix, WoutT, 2048, 2048, 2048, 0, 0}; pg8::StaticOrder S; S.init(M, 1024, G, bid);
        EpiWout E{XG2, rinv, ss1};
        pg8::gemm_phase<EpiWout, pg8::StaticOrder, PG_ALIGN_MAIN, false>(lds, g, S, E);
    }
    SEAM(4);
    if (IN(5)) {
        pg8::Gemm g{XG2, WincT, 1024, 1024, 1024, 0, 0}; pg8::StaticOrder S; S.init(M, 3072, G, bid);
        EpiWinC E{ss1, U2, SG2};
        pg8::gemm_phase<EpiWinC, pg8::StaticOrder, PG_ALIGN_MAIN, false>(lds, g, S, E);
    }
    SEAM(5);
    if (IN(6)) { ConvRegs CR; conv_load_regs(CR, conv_w, conv_b, conv_ln_g, conv_ln_b, tid); for (int rep = 0; rep < PROBE_CONV_REPS; ++rep) for (int it = bid; it < 1024; it += G) conv_item(rep == 0 ? 0 : PROBE_CONV_MODE, it, lds, U2, SG2, CR, V2, tid); }
    SEAM(6);
    if (IN(7)) {
        pg8::Gemm g{V2, WoutcT, 1024, 1024, 1024, 0, 0}; pg8::StaticOrder S; S.init(M, 1024, G, bid);
        EpiWoutC E{XG2, out, final_g, ss2, (unsigned*)(ws + WS_CTL + 262144)};
        pg8::gemm_phase<EpiWoutC, pg8::StaticOrder, true, false>(lds, g, S, E);
    }
#if PROBE_S5B2
    if (IN(8)) { pg8::Gemm g{Aext, Tg, AEXT_LD, AEXT_LD, AEXT_LD, 0, 0}; pg8::GroupOrder S{G, bid}; EpiYg E{Aext}; pg8::gemm_phase<EpiYg, pg8::GroupOrder, true, false>(lds, g, S, E); }
    if (IN(9)) { pg8::Gemm g{Aext, Tg, AEXT_LD, AEXT_LD, AEXT_LD, 0, 0}; pg8::GroupOrder S{G, bid}; EpiNull E{}; pg8::gemm_phase<EpiNull, pg8::GroupOrder, true, false>(lds, g, S, E); }
#endif
    if (PROBE_TS_A >= 0) {
        xcd_barrier(xbar);
        if (bid == 0) { if (tid == 0) tsw[N_PHASES] = __builtin_amdgcn_s_memrealtime(); __syncthreads();
            const long long K = (long long)(tsw[PROBE_TS_B] - tsw[PROBE_TS_A]) * 4;
            for (long long i = tid; i < K; i += NTHR) out[i * 8 + 3] += 0.125f; }
    }
#undef IN
#undef SEAM
}

extern "C" void kernel_launch(void* const* d_in, const int* in_sizes, int n_in, void* d_out, int out_size, void* d_ws, size_t ws_size, hipStream_t stream) {
    static int grid = 0;
    if (grid == 0) {
        if (n_in != 21 || out_size != M * DM || ws_size < WS_END) { fprintf(stderr, "kernel_launch: unexpected shapes (n_in %d, out %d, ws %zu)\n", n_in, out_size, ws_size); grid = -1; return; }
        int dev = 0, cus = 0, per_cu = 0;
        if (hipGetDevice(&dev) != hipSuccess || hipDeviceGetAttribute(&cus, hipDeviceAttributeMultiprocessorCount, dev) != hipSuccess) { grid = -1; return; }
        if (hipFuncSetAttribute((const void*)fwd_megakernel, hipFuncAttributeMaxDynamicSharedMemorySize, LDS_BYTES) != hipSuccess) { fprintf(stderr, "kernel_launch: hipFuncSetAttribute failed\n"); grid = -1; return; }
        if (hipOccupancyMaxActiveBlocksPerMultiprocessor(&per_cu, (const void*)fwd_megakernel, NTHR, LDS_BYTES) != hipSuccess || per_cu < 1) { fprintf(stderr, "kernel_launch: occupancy query says %d\n", per_cu); per_cu = 1; }
        (void)hipGetLastError();
        grid = cus;
    }
    if (grid < 0) return;
    (void)hipMemsetAsync((char*)d_ws + WS_CTL, 0, CTL_ZERO_BYTES, stream);
    Args a{};
    for (int i = 0; i < 21; ++i) a.in[i] = (const float*)d_in[i];
    a.out = (float*)d_out; a.ws = (unsigned char*)d_ws;
#if MK_PER_PHASE
    for (int p = 0; p < N_PHASES; ++p) { a.ph_lo = p; a.ph_hi = p + 1; const int reps = ((PROBE_DUP_MASK >> p) & 1) ? 2 : 1;
        for (int r = 0; r < reps; ++r) hipLaunchKernelGGL(fwd_megakernel, dim3(grid), dim3(NTHR), LDS_BYTES, stream, a);
#if PROBE_S5B2
        if (p == 2) { for (int r = 0; r < 2; ++r) { a.ph_lo = 7 + PROBE_S5B2; a.ph_hi = 8 + PROBE_S5B2; hipLaunchKernelGGL(fwd_megakernel, dim3(grid), dim3(NTHR), LDS_BYTES, stream, a); } }
#endif
    }
#else
    a.ph_lo = 0; a.ph_hi = N_PHASES;
    void* kargs[] = {&a};
    hipError_t e = hipLaunchCooperativeKernel((const void*)fwd_megakernel, dim3(grid), dim3(NTHR), kargs, LDS_BYTES, stream);
    if (e != hipSuccess) fprintf(stderr, "kernel_launch: cooperative launch failed: %s (grid %d)\n", hipGetErrorString(e), grid);
#endif
}
```
